# Optimizing an MI355X kernel written in HIP

```python
import jax, jax.numpy as jnp
from jax import lax
import numpy as np

D_MODEL = 2048
BATCH = 4
SEQ = 4096
DEPTH = 2

GRID_W = 64
CTX_LEN = 256
F_WIDTH = 1024
F_GROUPS = 8
F_GROUP_DIM = F_WIDTH // F_GROUPS
C_WIDTH = 1024
CONV_K = 31
N_HEADS = 16
QK_NOPE = 128
QK_ROPE = 64
V_DIM = 128
Q_LORA = 768
KV_LORA = 512
ROPE_BASE = 10000.0
ATTN_SCALE = (QK_NOPE + QK_ROPE) ** -0.5
Q_BLOCK = 128
N_BRANCH = 3
FFN_HIDDEN = -(-8 * D_MODEL // (3 * 256)) * 256
EPS = 1e-6
F_END = F_WIDTH
C_END = F_END + 2 * C_WIDTH
Q_END = C_END + Q_LORA
KV_END = Q_END + KV_LORA
KPE_END = KV_END + QK_ROPE
IN_COLS = KPE_END + N_BRANCH * D_MODEL

kernel_name = "hybrid_fnet_conformer_mla_dit_block"


def rmsnorm(x, g):
    xf = x.astype(jnp.float32)
    y = xf * lax.rsqrt(jnp.mean(xf * xf, axis=-1, keepdims=True) + EPS)
    return (y * g.astype(jnp.float32)).astype(x.dtype)


def layernorm(x, g, b):
    xf = x.astype(jnp.float32)
    mu = jnp.mean(xf, axis=-1, keepdims=True)
    var = jnp.mean(jnp.square(xf - mu), axis=-1, keepdims=True)
    y = (xf - mu) * lax.rsqrt(var + EPS)
    return (y * g.astype(jnp.float32) + b.astype(jnp.float32)).astype(x.dtype)


def modulate(h, shift, scale):
    return h * (1 + scale[:, None, :]) + shift[:, None, :]


def rope_2d(n_tok):
    rows = n_tok // GRID_W
    row = jnp.broadcast_to(jnp.arange(rows, dtype=jnp.float32)[:, None], (rows, GRID_W)).reshape(-1)
    col = jnp.broadcast_to(jnp.arange(GRID_W, dtype=jnp.float32)[None, :], (rows, GRID_W)).reshape(-1)
    n_freq = QK_ROPE // 4
    inv_freq = ROPE_BASE ** (-jnp.arange(n_freq, dtype=jnp.float32) / n_freq)
    ang = jnp.concatenate([row[:, None] * inv_freq, col[:, None] * inv_freq], axis=-1)
    return jnp.cos(ang), jnp.sin(ang)


def apply_rope(x, cos, sin):
    half = QK_ROPE // 2
    xf = x.astype(jnp.float32)
    x1, x2 = xf[..., :half], xf[..., half:]
    return jnp.concatenate([x1 * cos - x2 * sin, x1 * sin + x2 * cos], axis=-1).astype(x.dtype)


def fourier_mix(u):
    b, n, _ = u.shape
    uf = u.astype(jnp.float32).reshape(b, n, F_GROUPS, F_GROUP_DIM)
    y = jnp.fft.fft2(uf, axes=(1, 3), norm="ortho").real
    return y.reshape(b, n, F_WIDTH).astype(u.dtype)


def conformer_conv(u, lp):
    a, g = u[..., :C_WIDTH], u[..., C_WIDTH:]
    v = a * jax.nn.sigmoid(g)
    v = lax.conv_general_dilated(
        v, lp["conv_w"][:, None, :], window_strides=(1,),
        padding=[(CONV_K // 2, CONV_K // 2)],
        dimension_numbers=("NWC", "WIO", "NWC"),
        feature_group_count=C_WIDTH) + lp["conv_b"]
    v = jax.nn.silu(layernorm(v, lp["conv_ln_g"], lp["conv_ln_b"]))
    return v @ lp["w_conv_out"]


def mla_query(q_down, lp, rope):
    b, n, _ = q_down.shape
    q = (rmsnorm(q_down, lp["q_norm_g"]) @ lp["w_uq"]).reshape(b, n, N_HEADS, QK_NOPE + QK_ROPE)
    q_nope, q_pe = q[..., :QK_NOPE], q[..., QK_NOPE:]
    if rope is not None:
        q_pe = apply_rope(q_pe, rope[0][:, None, :], rope[1][:, None, :])
    return q_nope, q_pe


def mla_keys(kv_down, k_pe, lp, rope):
    b, n, _ = kv_down.shape
    kv = (rmsnorm(kv_down, lp["kv_norm_g"]) @ lp["w_ukv"]).reshape(b, n, N_HEADS, QK_NOPE + V_DIM)
    k_nope, v = kv[..., :QK_NOPE], kv[..., QK_NOPE:]
    if rope is not None:
        k_pe = apply_rope(k_pe, rope[0], rope[1])
    return k_nope, k_pe, v


def attend(q_nope, q_pe, k_nope, k_pe, v):
    s = (jnp.einsum("bqhd,bkhd->bhqk", q_nope, k_nope)
         + jnp.einsum("bqhd,bkd->bhqk", q_pe, k_pe)).astype(jnp.float32) * ATTN_SCALE
    p = jax.nn.softmax(s, axis=-1).astype(v.dtype)
    return jnp.einsum("bhqk,bkhd->bqhd", p, v)


def blocked_attention(q_nope, q_pe, k_nope, k_pe, v):
    b, n = q_nope.shape[:2]
    nb = n // Q_BLOCK
    qn = q_nope.reshape(b, nb, Q_BLOCK, N_HEADS, QK_NOPE).swapaxes(0, 1)
    qp = q_pe.reshape(b, nb, Q_BLOCK, N_HEADS, QK_ROPE).swapaxes(0, 1)
    o = lax.map(lambda qs: attend(qs[0], qs[1], k_nope, k_pe, v), (qn, qp))
    return o.swapaxes(0, 1).reshape(b, n, N_HEADS * V_DIM)


def merge_branches(proj, attn_o, lp):
    y_f = fourier_mix(proj[..., :F_END]) @ lp["w_fourier"]
    y_c = conformer_conv(proj[..., F_END:C_END], lp)
    y_a = attn_o @ lp["w_mla_o"]
    g = jax.nn.sigmoid(proj[..., KPE_END:] + lp["b_gate"])
    g_f, g_c, g_a = jnp.split(g, N_BRANCH, axis=-1)
    return (g_f * y_f + g_c * y_c + g_a * y_a) @ lp["w_out"]


def swiglu(h, lp):
    return (jax.nn.silu(h @ lp["w_ffn_gate"]) * (h @ lp["w_ffn_up"])) @ lp["w_ffn_down"]


def setup_inputs(seed: int = 0) -> dict:
    key = jax.random.key(seed)
    ks = jax.random.split(key, 26)

    def nrm(k, shape, scale):
        return jax.random.normal(k, shape, jnp.float32) * scale

    def gain(k, shape):
        return 1.0 + 0.02 * jax.random.normal(k, shape, jnp.float32)

    return {
        "x": nrm(ks[0], (BATCH, SEQ, D_MODEL), 1.0),
        "c": nrm(ks[1], (BATCH, D_MODEL), 1.0),
        "ctx": nrm(ks[2], (BATCH, CTX_LEN, D_MODEL), 1.0),
        "c_ctx": nrm(ks[3], (D_MODEL,), 1.0),
        "ada_w": nrm(ks[4], (DEPTH, D_MODEL, 6 * D_MODEL), 0.5 * D_MODEL ** -0.5),
        "ada_b": nrm(ks[5], (DEPTH, 6 * D_MODEL), 0.02),
        "norm_mix_g": gain(ks[6], (DEPTH, D_MODEL)),
        "w_in": nrm(ks[7], (DEPTH, D_MODEL, IN_COLS), D_MODEL ** -0.5),
        "b_gate": nrm(ks[8], (DEPTH, N_BRANCH * D_MODEL), 0.02),
        "w_fourier": nrm(ks[9], (DEPTH, F_WIDTH, D_MODEL), F_WIDTH ** -0.5),
        "conv_w": nrm(ks[10], (DEPTH, CONV_K, C_WIDTH), CONV_K ** -0.5),
        "conv_b": nrm(ks[11], (DEPTH, C_WIDTH), 0.02),
        "conv_ln_g": gain(ks[12], (DEPTH, C_WIDTH)),
        "conv_ln_b": nrm(ks[13], (DEPTH, C_WIDTH), 0.02),
        "w_conv_out": nrm(ks[14], (DEPTH, C_WIDTH, D_MODEL), C_WIDTH ** -0.5),
        "q_norm_g": gain(ks[15], (DEPTH, Q_LORA)),
        "w_uq": nrm(ks[16], (DEPTH, Q_LORA, N_HEADS * (QK_NOPE + QK_ROPE)), Q_LORA ** -0.5),
        "kv_norm_g": gain(ks[17], (DEPTH, KV_LORA)),
        "w_ukv": nrm(ks[18], (DEPTH, KV_LORA, N_HEADS * (QK_NOPE + V_DIM)), KV_LORA ** -0.5),
        "w_mla_o": nrm(ks[19], (DEPTH, N_HEADS * V_DIM, D_MODEL), (N_HEADS * V_DIM) ** -0.5),
        "w_out": nrm(ks[20], (DEPTH, D_MODEL, D_MODEL), D_MODEL ** -0.5),
        "norm_ffn_g": gain(ks[21], (DEPTH, D_MODEL)),
        "w_ffn_gate": nrm(ks[22], (DEPTH, D_MODEL, FFN_HIDDEN), D_MODEL ** -0.5),
        "w_ffn_up": nrm(ks[23], (DEPTH, D_MODEL, FFN_HIDDEN), D_MODEL ** -0.5),
        "w_ffn_down": nrm(ks[24], (DEPTH, FFN_HIDDEN, D_MODEL), FFN_HIDDEN ** -0.5),
        "final_norm_g": gain(ks[25], (D_MODEL,)),
    }


def reference(x, c, ctx, c_ctx, ada_w, ada_b, norm_mix_g, w_in, b_gate, w_fourier,
              conv_w, conv_b, conv_ln_g, conv_ln_b, w_conv_out, q_norm_g, w_uq,
              kv_norm_g, w_ukv, w_mla_o, w_out, norm_ffn_g, w_ffn_gate, w_ffn_up,
              w_ffn_down, final_norm_g):
    rope = rope_2d(x.shape[1])
    b = x.shape[0]
    for i in range(DEPTH):
        last = i == DEPTH - 1
        lp = dict(b_gate=b_gate[i], w_fourier=w_fourier[i], conv_w=conv_w[i], conv_b=conv_b[i],
                  conv_ln_g=conv_ln_g[i], conv_ln_b=conv_ln_b[i], w_conv_out=w_conv_out[i],
                  q_norm_g=q_norm_g[i], w_uq=w_uq[i], kv_norm_g=kv_norm_g[i], w_ukv=w_ukv[i],
                  w_mla_o=w_mla_o[i], w_out=w_out[i], w_ffn_gate=w_ffn_gate[i],
                  w_ffn_up=w_ffn_up[i], w_ffn_down=w_ffn_down[i])
        mod = jax.nn.silu(c) @ ada_w[i] + ada_b[i]
        mod_c = jax.nn.silu(c_ctx)[None, :] @ ada_w[i] + ada_b[i]
        sh1, sc1, g1, sh2, sc2, g2 = jnp.split(mod, 6, axis=-1)
        csh1, csc1, cg1, csh2, csc2, cg2 = jnp.split(mod_c, 6, axis=-1)

        hx = modulate(rmsnorm(x, norm_mix_g[i]), sh1, sc1)
        hc = modulate(rmsnorm(ctx, norm_mix_g[i]), csh1, csc1)
        px = hx @ w_in[i]
        if last:
            pkv = hc @ w_in[i][:, Q_END:KPE_END]
            kv_c, kpe_c = pkv[..., :KV_LORA], pkv[..., KV_LORA:]
        else:
            pc = hc @ w_in[i]
            kv_c, kpe_c = pc[..., Q_END:KV_END], pc[..., KV_END:KPE_END]

        qn_x, qp_x = mla_query(px[..., C_END:Q_END], lp, rope)
        kn_x, kp_x, v_x = mla_keys(px[..., Q_END:KV_END], px[..., KV_END:KPE_END], lp, rope)
        kn_c, kp_c, v_c = mla_keys(kv_c, kpe_c, lp, None)
        o_x = blocked_attention(qn_x, qp_x,
                                jnp.concatenate([kn_x, kn_c], axis=1),
                                jnp.concatenate([kp_x, kp_c], axis=1),
                                jnp.concatenate([v_x, v_c], axis=1))
        x_mixed = x + g1[:, None, :] * merge_branches(px, o_x, lp)

        if not last:
            qn_c, qp_c = mla_query(pc[..., C_END:Q_END], lp, None)
            o_c = attend(qn_c, qp_c, kn_c, kp_c, v_c).reshape(b, ctx.shape[1], N_HEADS * V_DIM)
            ctx = ctx + cg1[:, None, :] * merge_branches(pc, o_c, lp)
            ctx = ctx + cg2[:, None, :] * swiglu(modulate(rmsnorm(ctx, norm_ffn_g[i]), csh2, csc2), lp)

        x = x_mixed + g2[:, None, :] * swiglu(modulate(rmsnorm(x_mixed, norm_ffn_g[i]), sh2, sc2), lp)
    return rmsnorm(x, final_norm_g)
```

```cpp
#include <hip/hip_runtime.h>
#include <hip/hip_cooperative_groups.h>
#include <cstdio>
#include <cstdint>
namespace cg = cooperative_groups;

#define LAS __attribute__((address_space(3)))
typedef unsigned short bf16_t;
typedef short bf16x8 __attribute__((ext_vector_type(8)));
typedef short s16x4 __attribute__((ext_vector_type(4)));
typedef float f32x4 __attribute__((ext_vector_type(4)));
typedef float f32x2 __attribute__((ext_vector_type(2)));
typedef float f32x16 __attribute__((ext_vector_type(16)));
typedef unsigned u32x4 __attribute__((ext_vector_type(4)));
typedef unsigned u32x2 __attribute__((ext_vector_type(2)));

constexpr int DM = 2048, NB = 4, SEQ = 4096, CTXL = 256;
constexpr int MX = NB * SEQ, MC = NB * CTXL, MT = MX + MC;
constexpr int KVS = SEQ + CTXL;
constexpr int F_END = 1024, C_END = 3072, Q_END = 3840, KV_END = 4352, KPE_END = 4416, IN_COLS = 10560;
constexpr int FFH = 5632;
constexpr float EPS = 1e-6f;

struct Params {
  const float *x, *c, *ctx, *c_ctx, *ada_w, *ada_b, *norm_mix_g, *w_in, *b_gate, *w_fourier, *conv_w, *conv_b, *conv_ln_g, *conv_ln_b,
      *w_conv_out, *q_norm_g, *w_uq, *kv_norm_g, *w_ukv, *w_mla_o, *w_out, *norm_ffn_g, *w_ffn_gate, *w_ffn_up, *w_ffn_down, *final_norm_g;
  float* out; unsigned char* ws; int ph_lo, ph_hi;
};

typedef const __attribute__((address_space(4))) Params* KArgP;
__device__ __forceinline__ KArgP kargs() { KArgP q = (KArgP)__builtin_amdgcn_kernarg_segment_ptr(); asm volatile("" : "+s"(q)); return q; }

constexpr size_t MiB = 1u << 20;
constexpr size_t WS_FLAGS = 0, WS_SSQQ = 64 * 1024, WS_SSQKV = 192 * 1024, WS_MODS = 512 * 1024, WS_ROPEC = 1 * MiB, WS_ROPES = 1 * MiB + 512 * 1024,
                 WS_CS1 = 2 * MiB, WS_DFTC = 2 * MiB + 256 * 1024,
                 WS_FFTA = 2 * MiB + 512 * 1024, WS_FFTC = WS_FFTA + 64 * 1024, WS_TWC = WS_FFTC + 64 * 1024, WS_TWS = WS_TWC + 16 * 1024;
constexpr size_t WS_CTXX = 4 * MiB, WS_GP = 12 * MiB;
constexpr size_t WS_WIN = 76 * MiB, WS_WF = 118 * MiB, WS_WC = 122 * MiB, WS_WUQ = 126 * MiB, WS_WUKV = 131 * MiB, WS_WMLA = 135 * MiB, WS_WOUT = 143 * MiB,
                 WS_WGU = 151 * MiB, WS_WDN = 195 * MiB;
constexpr size_t WS_H = 217 * MiB, WS_Q = 285 * MiB, WS_TMPG = 285 * MiB, WS_HID = 285 * MiB, WS_KN = 387 * MiB, WS_MERGED = 387 * MiB, WS_V = 455 * MiB,
                 WS_ZT = 523 * MiB, WS_ZTC = 587 * MiB, WS_CBF = 591 * MiB, WS_KPE = 625 * MiB, WS_UF = 628 * MiB, WS_O = 628 * MiB, WS_VB = 662 * MiB,
                 WS_QD = 696 * MiB, WS_F = 696 * MiB, WS_KVD = 722 * MiB, WS_GATEC = 739 * MiB, WS_YC = 751 * MiB, WS_PART = 763 * MiB, WS_END = 795 * MiB;

typedef __bf16 bf16x2_t __attribute__((ext_vector_type(2)));
__device__ __forceinline__ unsigned cvt_pk(float lo, float hi) { f32x2 v = {lo, hi}; bf16x2_t b = __builtin_convertvector(v, bf16x2_t); return __builtin_bit_cast(unsigned, b); }
__device__ __forceinline__ int opaque(int v) { asm volatile("" : "+v"(v)); return v; }
__device__ __forceinline__ float bflo(unsigned w) { return __uint_as_float(w << 16); }
__device__ __forceinline__ float bfhi(unsigned w) { return __uint_as_float(w & 0xffff0000u); }
__device__ __forceinline__ float fsigmoid(float x) { return __builtin_amdgcn_rcpf(1.f + __expf(-x)); }
__device__ __forceinline__ float wave_sum(float v) {
#pragma unroll
  for (int o = 1; o < 64; o <<= 1) v += __shfl_xor(v, o);
  return v;
}
__device__ __forceinline__ u32x4 pack8(f32x4 a, f32x4 b) { u32x4 w; w.x = cvt_pk(a[0], a[1]); w.y = cvt_pk(a[2], a[3]); w.z = cvt_pk(b[0], b[1]); w.w = cvt_pk(b[2], b[3]); return w; }
__device__ __forceinline__ int kvrow(int row) { return row < MX ? (row >> 12) * KVS + (row & 4095) : ((row - MX) >> 8) * KVS + SEQ + ((row - MX) & 255); }
__device__ __forceinline__ int modgrp(int row) { return row < MX ? (row >> 12) : 4; }

namespace pg8 {
constexpr int BM = 256, BK = 64, HALF = 128, HTB = HALF * BK * 2, STAGE_BYTES = 8 * HTB, NXCD = 8, WGM = 8;
__host__ __device__ __forceinline__ int lds_byte(int r, int c) { const int st = (r >> 4) * 2 + (c >> 5), rr = r & 15, cc = c & 31, ob = rr * 64 + cc * 2; return st * 1024 + (ob ^ (((ob >> 9) & 1) << 5)); }
__host__ __device__ __forceinline__ void stage_rc(int b, int& R, int& C) { const int st = b / 1024, sb = b % 1024, swz = sb ^ (((sb >> 9) & 1) << 5); R = (st >> 1) * 16 + swz / 64; C = (st & 1) * 32 + (swz % 64) / 2; }
__host__ __device__ __forceinline__ int perm32(int rho) { const int n = rho >> 4, i = rho & 15; return 8 * (i >> 2) + 4 * n + (i & 3); }
struct Unit { int pm, pn; };
struct Order {
  int nM, nN, nwg, G, c;
  __device__ void init(int nM_, int nN_, int G_, int c_) { nM = nM_; nN = nN_; nwg = nM * nN; G = G_; c = c_; }
  __device__ bool next(int i, Unit& u) const {
    const long L = (long)i * G + c; if (L >= nwg) return false;
    int wgid = (int)L; { const int q = nwg / NXCD, r = nwg % NXCD, xcd = wgid % NXCD, off = wgid / NXCD; wgid = (xcd < r ? xcd * (q + 1) : r * (q + 1) + (xcd - r) * q) + off; }
    const int nig = WGM * nN, gid = wgid / nig, fm = gid * WGM, gsz = (nM - fm) < WGM ? (nM - fm) : WGM;
    u.pm = fm + ((wgid % nig) % gsz); u.pn = (wgid % nig) / gsz; return true;
  }
};
enum { GEO_STD = 0, GEO_DFT1 = 1, GEO_DFT2 = 2, GEO_SPLITK = 3, GEO_A0 = 4 };
struct Geo {
  int mode; int lda, ldb; int aux;
  __device__ __forceinline__ size_t aoff(const Unit& u) const { if (mode == GEO_SPLITK) return (size_t)u.pm * BM * lda * 2 + (size_t)(u.pn >> 3) * aux * 2;
    return (mode == GEO_DFT1 || mode == GEO_A0) ? 0 : (size_t)u.pm * BM * lda * 2; }
  __device__ __forceinline__ size_t boff(const Unit& u) const {
    if (mode == GEO_STD) return (size_t)u.pn * BM * ldb * 2;
    if (mode == GEO_SPLITK) return (size_t)(u.pn & 7) * BM * ldb * 2 + (size_t)(u.pn >> 3) * aux * 2;
    if (mode == GEO_A0) return (size_t)u.pn * BM * ldb * 2;
    if (mode == GEO_DFT1) { const int tp = aux ? 1 : 16, seqlen = aux ? CTXL : SEQ; const int bg = u.pn / tp, pt = u.pn % tp, b = bg >> 3, g = bg & 7;
      return ((size_t)(b * seqlen + pt * (aux ? 256 : 4)) * 1024 + g * 128) * 2; }
    const int zl = aux ? 512 : 8192; const int b = u.pn >> 2, ct = u.pn & 3; return ((size_t)(b * 1024 + ct * 256) * zl) * 2;
  }
};

enum { E_IN = 0, E_DFT1, E_UQ, E_UKV, E_DFT2, E_GATE, E_Y, E_RES, E_UP, E_YC, E_FFTA, E_FFTC };
struct Epi {
  int mode; int pm_off, pn_off; int aux; int l; unsigned char* ws;
  __device__ __forceinline__ void operator()(const f32x4 (&acc)[2][2][4][2], const Unit& u, int wr, int wc, int fr_in, int fq_in) const {
    const int fr = opaque(fr_in), fq = opaque(fq_in);
    bf16_t *o0 = nullptr, *o1 = nullptr, *o2 = nullptr, *o3 = nullptr, *o4 = nullptr; const bf16_t* g0 = nullptr; float *s0 = nullptr, *s1 = nullptr; const float *c0 = nullptr, *c1 = nullptr;
    const float *xin_l = nullptr, *xin_c = nullptr; float *xout_l = nullptr, *xout_c = nullptr; int first = 0, seqlen = 0, tp = 1, zl = 0, rowbase = 0;
    switch (mode) {
      case E_IN: o0 = (bf16_t*)(ws + WS_UF); o1 = (bf16_t*)(ws + WS_VB); o2 = (bf16_t*)(ws + WS_QD); o3 = (bf16_t*)(ws + WS_KVD); o4 = (bf16_t*)(ws + WS_KPE);
        s0 = (float*)(ws + WS_SSQQ); s1 = (float*)(ws + WS_SSQKV); c0 = (const float*)(ws + WS_ROPEC); c1 = (const float*)(ws + WS_ROPES); break;
      case E_DFT1: o0 = (bf16_t*)(ws + (aux ? WS_ZTC : WS_ZT)); tp = aux ? 1 : 16; zl = aux ? 512 : 8192; break;
      case E_UQ: o0 = (bf16_t*)(ws + WS_Q); s0 = (float*)(ws + WS_SSQQ); c0 = (const float*)(ws + WS_ROPEC); c1 = (const float*)(ws + WS_ROPES); break;
      case E_UKV: o0 = (bf16_t*)(ws + WS_KN); o1 = (bf16_t*)(ws + WS_V); s1 = (float*)(ws + WS_SSQKV); break;
      case E_FFTA: o0 = (bf16_t*)(ws + WS_GP); c0 = (const float*)(ws + WS_TWC); c1 = (const float*)(ws + WS_TWS); break;
      case E_FFTC: o0 = (bf16_t*)(ws + WS_F); break;
      case E_DFT2: o0 = (bf16_t*)(ws + WS_F); seqlen = aux ? CTXL : SEQ; rowbase = aux ? MX : 0; break;
      case E_GATE: o0 = (aux & 4) ? (bf16_t*)(ws + WS_GATEC) + (size_t)(aux & 3) * 1024 * 2048 - (size_t)MX * 2048 : (bf16_t*)(ws + WS_TMPG); c0 = kargs()->b_gate + (size_t)l * 6144 + (aux & 3) * 2048; break;
      case E_YC: o0 = (bf16_t*)(ws + WS_YC) + (size_t)aux * 1024 * 2048 - (size_t)MX * 2048; break;
      case E_Y: o0 = (bf16_t*)(ws + WS_MERGED); g0 = (const bf16_t*)(ws + WS_TMPG); first = aux; break;
      case E_RES: { KArgP ka = kargs(); float* outp = ka->out; float* cx = (float*)(ws + WS_CTXX); const bool fresh = ((aux & 1) == 0 && l == 0);
        c0 = (const float*)(ws + WS_MODS) + (size_t)l * 5 * 12288 + ((aux & 1) ? 5 : 2) * 2048; xin_l = fresh ? ka->x : outp; xin_c = fresh ? ka->ctx : cx; xout_l = outp; xout_c = cx; break; }
      default: o0 = (bf16_t*)(ws + WS_HID); break;
    }
    const int pm = u.pm + pm_off, pn = u.pn + pn_off;
    const int cin = 32 * wc + 8 * fq;
    if (mode == E_IN) {
      if (pn < 4) {
#pragma unroll
        for (int ai = 0; ai < 2; ++ai)
#pragma unroll
          for (int m = 0; m < 4; ++m) { const int row = pm * 256 + ai * 128 + wr * 64 + m * 16 + fr;
#pragma unroll
            for (int bj = 0; bj < 2; ++bj) *(u32x4*)(o0 + (size_t)row * 1024 + pn * 256 + bj * 128 + cin) = pack8(acc[ai][bj][m][0], acc[ai][bj][m][1]); }
      } else if (pn < 12) {
        const int t = pn - 4;
#pragma unroll
        for (int ai = 0; ai < 2; ++ai)
#pragma unroll
          for (int m = 0; m < 4; ++m) { const int row = pm * 256 + ai * 128 + wr * 64 + m * 16 + fr;
            f32x4 v0, v1;
#pragma unroll
            for (int j = 0; j < 4; ++j) { v0[j] = acc[ai][0][m][0][j] * fsigmoid(acc[ai][1][m][0][j]); v1[j] = acc[ai][0][m][1][j] * fsigmoid(acc[ai][1][m][1][j]); }
            *(u32x4*)(o1 + (size_t)row * 1024 + t * 128 + cin) = pack8(v0, v1); }
      } else if (pn < 17) {
        const bool isq = pn < 15; bf16_t* ob = isq ? o2 : o3; const int ld = isq ? 768 : 512; const int ct = isq ? pn - 12 : pn - 15; float* ssq = isq ? s0 : s1;
#pragma unroll
        for (int ai = 0; ai < 2; ++ai)
#pragma unroll
          for (int m = 0; m < 4; ++m) { const int row = pm * 256 + ai * 128 + wr * 64 + m * 16 + fr; float s = 0.f;
#pragma unroll
            for (int bj = 0; bj < 2; ++bj) { const f32x4 a = acc[ai][bj][m][0], b = acc[ai][bj][m][1];
              s += (a[0] * a[0] + a[1] * a[1]) + (a[2] * a[2] + a[3] * a[3]) + (b[0] * b[0] + b[1] * b[1]) + (b[2] * b[2] + b[3] * b[3]);
              *(u32x4*)(ob + (size_t)row * ld + ct * 256 + bj * 128 + cin) = pack8(a, b); }
            s += __shfl_xor(s, 16); s += __shfl_xor(s, 32);
            if (fq == 0) atomicAdd(ssq + row, s); }
      } else {
        if (wc == 0) {
#pragma unroll
          for (int ai = 0; ai < 2; ++ai)
#pragma unroll
            for (int m = 0; m < 4; ++m) { const int row = pm * 256 + ai * 128 + wr * 64 + m * 16 + fr;
              f32x4 x1a = acc[ai][0][m][0], x1b = acc[ai][0][m][1], x2a = acc[ai][1][m][0], x2b = acc[ai][1][m][1], y1a = x1a, y1b = x1b, y2a = x2a, y2b = x2b;
              if (row < MX) { const int pos = row & 4095; const f32x4 ca = *(const f32x4*)(c0 + pos * 32 + cin), cb = *(const f32x4*)(c0 + pos * 32 + cin + 4), sa = *(const f32x4*)(c1 + pos * 32 + cin), sb = *(const f32x4*)(c1 + pos * 32 + cin + 4);
                y1a = x1a * ca - x2a * sa; y1b = x1b * cb - x2b * sb; y2a = x1a * sa + x2a * ca; y2b = x1b * sb + x2b * cb; }
              const int kr = kvrow(row);
              *(u32x4*)(o4 + (size_t)kr * 64 + cin) = pack8(y1a, y1b); *(u32x4*)(o4 + (size_t)kr * 64 + 32 + cin) = pack8(y2a, y2b); }
        }
      }
    } else if (mode == E_FFTA) {
      if (true) {
#pragma unroll
        for (int m2 = 0; m2 < 2; ++m2) { const int k1 = 32 * wr + 16 * m2 + fr;
#pragma unroll
          for (int bj = 0; bj < 2; ++bj) { const int nu = pn * 256 + bj * 128 + cin, n2 = nu & 63, chb = nu >> 6, ch = chb & 1023, b = chb >> 10;
            const f32x4 ca = *(const f32x4*)(c0 + k1 * 64 + n2), cb = *(const f32x4*)(c0 + k1 * 64 + n2 + 4), sa = *(const f32x4*)(c1 + k1 * 64 + n2), sb = *(const f32x4*)(c1 + k1 * 64 + n2 + 4);
            const f32x4 ra = acc[0][bj][m2][0], rb = acc[0][bj][m2][1], ia = acc[0][bj][m2 + 2][0], ib = acc[0][bj][m2 + 2][1];
            bf16_t* dst = o0 + ((size_t)((b * 64 + k1) * 1024 + ch)) * 128 + n2;
            *(u32x4*)dst = pack8(ra * ca + ia * sa, rb * cb + ib * sb); *(u32x4*)(dst + 64) = pack8(ia * ca - ra * sa, ib * cb - rb * sb); } }
      }
    } else if (mode == E_FFTC) {
      if (wr == 0) {
#pragma unroll
        for (int m = 0; m < 4; ++m) { const int k2 = 16 * m + fr;
#pragma unroll
          for (int bj = 0; bj < 2; ++bj) { const int nu = pn * 256 + bj * 128 + cin, ch = nu & 1023, k1 = (nu >> 10) & 63, b = nu >> 16;
            *(u32x4*)(o0 + ((size_t)(b * 4096 + k1 + 64 * k2)) * 1024 + ch) = pack8(acc[0][bj][m][0], acc[0][bj][m][1]); } }
      }
    } else if (mode == E_DFT1 && aux == 0) {
      const int bg = pn >> 4, pt = pn & 15, b = bg >> 3, g = bg & 7;
#pragma unroll
      for (int ai = 0; ai < 2; ++ai)
#pragma unroll
        for (int m = 0; m < 4; ++m) { const int l = wr * 64 + m * 16 + fr;
#pragma unroll
          for (int bj = 0; bj < 2; ++bj) { const int cl = bj * 128 + cin, n2 = 4 * pt + (cl >> 6), n1 = cl & 63;
            *(u32x4*)(o0 + ((size_t)((b * 1024 + g * 128 + l) * 64 + n2)) * 128 + ai * 64 + n1) = pack8(acc[ai][bj][m][0], acc[ai][bj][m][1]); } }
    } else if (mode == E_DFT1) {
      const int bg = pn / tp, pt = pn % tp, b = bg >> 3, g = bg & 7;
#pragma unroll
      for (int ai = 0; ai < 2; ++ai)
#pragma unroll
        for (int m = 0; m < 4; ++m) { const int l = wr * 64 + m * 16 + fr;
#pragma unroll
          for (int bj = 0; bj < 2; ++bj) *(u32x4*)(o0 + (size_t)(b * 1024 + g * 128 + l) * zl + ai * (zl >> 1) + pt * 256 + bj * 128 + cin) = pack8(acc[ai][bj][m][0], acc[ai][bj][m][1]); }
    } else if (mode == E_UQ) {
#pragma unroll
      for (int ai = 0; ai < 2; ++ai)
#pragma unroll
        for (int m = 0; m < 4; ++m) { const int row = pm * 256 + ai * 128 + wr * 64 + m * 16 + fr; const float rs = 1.0f / sqrtf(s0[row] * (1.f / 768.f) + EPS);
          if (pn < 8) {
#pragma unroll
            for (int bj = 0; bj < 2; ++bj) *(u32x4*)(o0 + (size_t)row * 3072 + (2 * pn + bj) * 192 + cin) = pack8(acc[ai][bj][m][0] * rs, acc[ai][bj][m][1] * rs);
          } else {
            const int head = 4 * (pn - 8) + wc, i0 = 8 * fq;
            f32x4 x1a = acc[ai][0][m][0] * rs, x1b = acc[ai][0][m][1] * rs, x2a = acc[ai][1][m][0] * rs, x2b = acc[ai][1][m][1] * rs, y1a = x1a, y1b = x1b, y2a = x2a, y2b = x2b;
            if (row < MX) { const int pos = row & 4095; const f32x4 ca = *(const f32x4*)(c0 + pos * 32 + i0), cb = *(const f32x4*)(c0 + pos * 32 + i0 + 4), sa = *(const f32x4*)(c1 + pos * 32 + i0), sb = *(const f32x4*)(c1 + pos * 32 + i0 + 4);
              y1a = x1a * ca - x2a * sa; y1b = x1b * cb - x2b * sb; y2a = x1a * sa + x2a * ca; y2b = x1b * sb + x2b * cb; }
            *(u32x4*)(o0 + (size_t)row * 3072 + head * 192 + 128 + i0) = pack8(y1a, y1b); *(u32x4*)(o0 + (size_t)row * 3072 + head * 192 + 160 + i0) = pack8(y2a, y2b);
          } }
    } else if (mode == E_UKV) {
      bf16_t* ob = pn < 8 ? o0 : o1; const int ct = pn < 8 ? pn : pn - 8;
#pragma unroll
      for (int ai = 0; ai < 2; ++ai)
#pragma unroll
        for (int m = 0; m < 4; ++m) { const int row = pm * 256 + ai * 128 + wr * 64 + m * 16 + fr; const float rs = 1.0f / sqrtf(s1[row] * (1.f / 512.f) + EPS); const int kr = kvrow(row);
#pragma unroll
          for (int bj = 0; bj < 2; ++bj) *(u32x4*)(ob + (size_t)kr * 2048 + ct * 256 + bj * 128 + cin) = pack8(acc[ai][bj][m][0] * rs, acc[ai][bj][m][1] * rs); }
    } else if (mode == E_DFT2) {
      const int b = pn >> 2, ct = pn & 3;
#pragma unroll
      for (int ai = 0; ai < 2; ++ai)
#pragma unroll
        for (int m = 0; m < 4; ++m) { const int row = rowbase + b * seqlen + pm * 256 + ai * 128 + wr * 64 + m * 16 + fr;
#pragma unroll
          for (int bj = 0; bj < 2; ++bj) *(u32x4*)(o0 + (size_t)row * 1024 + ct * 256 + bj * 128 + cin) = pack8(acc[ai][bj][m][0], acc[ai][bj][m][1]); }
    } else if (mode == E_GATE) {
#pragma unroll
      for (int bj = 0; bj < 2; ++bj) { const int col = pn * 256 + bj * 128 + cin; const f32x4 ba = *(const f32x4*)(c0 + col), bb = *(const f32x4*)(c0 + col + 4);
#pragma unroll
        for (int ai = 0; ai < 2; ++ai)
#pragma unroll
          for (int m = 0; m < 4; ++m) { const int row = pm * 256 + ai * 128 + wr * 64 + m * 16 + fr; f32x4 v0, v1;
#pragma unroll
            for (int j = 0; j < 4; ++j) { v0[j] = fsigmoid(acc[ai][bj][m][0][j] + ba[j]); v1[j] = fsigmoid(acc[ai][bj][m][1][j] + bb[j]); }
            *(u32x4*)(o0 + (size_t)row * 2048 + col) = pack8(v0, v1); } }
    } else if (mode == E_Y) {
#pragma unroll
      for (int am = 0; am < 4; ++am) { const int ai = am >> 1, mb = (am & 1) * 2; u32x4 gw[2][2], mw[2][2];
#pragma unroll
        for (int mm = 0; mm < 2; ++mm)
#pragma unroll
          for (int bj = 0; bj < 2; ++bj) { const int row = pm * 256 + ai * 128 + wr * 64 + (mb + mm) * 16 + fr; const size_t off = (size_t)row * 2048 + pn * 256 + bj * 128 + cin;
            gw[mm][bj] = *(const u32x4*)(g0 + off); mw[mm][bj] = first ? (u32x4){0u, 0u, 0u, 0u} : *(const u32x4*)(o0 + off); }
        asm volatile("" ::: "memory");
#pragma unroll
        for (int mm = 0; mm < 2; ++mm)
#pragma unroll
          for (int bj = 0; bj < 2; ++bj) { const int m = mb + mm; const int row = pm * 256 + ai * 128 + wr * 64 + m * 16 + fr; const size_t off = (size_t)row * 2048 + pn * 256 + bj * 128 + cin; const u32x4 g_ = gw[mm][bj], m_ = mw[mm][bj];
            f32x4 v0, v1; v0[0] = bflo(g_.x) * acc[ai][bj][m][0][0] + bflo(m_.x); v0[1] = bfhi(g_.x) * acc[ai][bj][m][0][1] + bfhi(m_.x); v0[2] = bflo(g_.y) * acc[ai][bj][m][0][2] + bflo(m_.y); v0[3] = bfhi(g_.y) * acc[ai][bj][m][0][3] + bfhi(m_.y);
            v1[0] = bflo(g_.z) * acc[ai][bj][m][1][0] + bflo(m_.z); v1[1] = bfhi(g_.z) * acc[ai][bj][m][1][1] + bfhi(m_.z); v1[2] = bflo(g_.w) * acc[ai][bj][m][1][2] + bflo(m_.w); v1[3] = bfhi(g_.w) * acc[ai][bj][m][1][3] + bfhi(m_.w);
            *(u32x4*)(o0 + off) = pack8(v0, v1); }
        asm volatile("" ::: "memory"); }
    } else if (mode == E_YC) {
#pragma unroll
      for (int ai = 0; ai < 2; ++ai)
#pragma unroll
        for (int m = 0; m < 4; ++m) { const int row = pm * 256 + ai * 128 + wr * 64 + m * 16 + fr;
#pragma unroll
          for (int bj = 0; bj < 2; ++bj) *(u32x4*)(o0 + (size_t)row * 2048 + pn * 256 + bj * 128 + cin) = pack8(acc[ai][bj][m][0], acc[ai][bj][m][1]); }
    } else if (mode == E_RES) {
      if (aux & 8) {
        float* pb = (float*)(ws + WS_PART) + (size_t)(pn >> 3) * 1024 * 2048; const int pnn = pn & 7;
#pragma unroll
        for (int ai = 0; ai < 2; ++ai)
#pragma unroll
          for (int m = 0; m < 4; ++m) { const int row = pm * 256 + ai * 128 + wr * 64 + m * 16 + fr - MX;
#pragma unroll
            for (int bj = 0; bj < 2; ++bj) { float* q = pb + (size_t)row * 2048 + pnn * 256 + bj * 128 + cin; *(f32x4*)q = acc[ai][bj][m][0]; *(f32x4*)(q + 4) = acc[ai][bj][m][1]; } }
        return;
      }
      {
        const int row0 = pm * 256; const bool lat = row0 < MX; const int mg = modgrp(row0);
        const float* xi0 = lat ? xin_l + (size_t)row0 * 2048 : xin_c + (size_t)(row0 - MX) * 2048; float* xo0 = lat ? xout_l + (size_t)row0 * 2048 : xout_c + (size_t)(row0 - MX) * 2048;
        f32x4 ga[2], gb[2];
#pragma unroll
        for (int bj = 0; bj < 2; ++bj) { const int col = pn * 256 + bj * 128 + cin; ga[bj] = *(const f32x4*)(c0 + mg * 12288 + col); gb[bj] = *(const f32x4*)(c0 + mg * 12288 + col + 4); }
#pragma unroll
        for (int am = 0; am < 4; ++am) { const int ai = am >> 1, mb = (am & 1) * 2; f32x4 xa[2][2], xb[2][2];
#pragma unroll
          for (int mm = 0; mm < 2; ++mm)
#pragma unroll
            for (int bj = 0; bj < 2; ++bj) { const size_t off = (size_t)(ai * 128 + wr * 64 + (mb + mm) * 16 + fr) * 2048 + pn * 256 + bj * 128 + cin; xa[mm][bj] = *(const f32x4*)(xi0 + off); xb[mm][bj] = *(const f32x4*)(xi0 + off + 4); }
          asm volatile("" ::: "memory");
#pragma unroll
          for (int mm = 0; mm < 2; ++mm)
#pragma unroll
            for (int bj = 0; bj < 2; ++bj) { const size_t off = (size_t)(ai * 128 + wr * 64 + (mb + mm) * 16 + fr) * 2048 + pn * 256 + bj * 128 + cin;
              *(f32x4*)(xo0 + off) = xa[mm][bj] + ga[bj] * acc[ai][bj][mb + mm][0]; *(f32x4*)(xo0 + off + 4) = xb[mm][bj] + gb[bj] * acc[ai][bj][mb + mm][1]; }
          asm volatile("" ::: "memory"); }
      }
    } else {
#pragma unroll
      for (int ai = 0; ai < 2; ++ai)
#pragma unroll
        for (int m = 0; m < 4; ++m) { const int row = pm * 256 + ai * 128 + wr * 64 + m * 16 + fr; f32x4 v0, v1;
#pragma unroll
          for (int j = 0; j < 4; ++j) { const float a = acc[ai][0][m][0][j], b = acc[ai][0][m][1][j]; v0[j] = a * fsigmoid(a) * acc[ai][1][m][0][j]; v1[j] = b * fsigmoid(b) * acc[ai][1][m][1][j]; }
          *(u32x4*)(o0 + (size_t)row * FFH + pn * 128 + cin) = pack8(v0, v1); }
    }
  }
};

__device__ __forceinline__ void gemm_phase(LAS unsigned char* lds, const bf16_t* Aop, const bf16_t* Bop, int K, const Order& S, const Geo& geo, const Epi& E) {
  const int tid = opaque(threadIdx.x), wid = __builtin_amdgcn_readfirstlane(tid >> 6), lane = tid & 63, wr = wid >> 2, wc = wid & 3, fr = lane & 15, fq = lane >> 4;
  const int nt = K / BK;
  unsigned voffA[2], voffB[2];
  const bool rperm = (geo.mode == GEO_DFT1 && geo.aux == 0);
#pragma unroll
  for (int i = 0; i < 2; ++i) { int R, C; stage_rc(tid * 16 + i * 8192, R, C); const int Rb = (R & ~31) + perm32(R & 31); const int Rg = rperm ? 64 * (Rb & 63) + (Rb >> 6) : Rb;
    voffA[i] = (unsigned)(R * geo.lda + C) * 2u; voffB[i] = (unsigned)(Rg * geo.ldb + C) * 2u; }
  const size_t kstep = (size_t)(BK * 2);
  const size_t hstepA = (size_t)HALF * geo.lda * 2, hstepB = rperm ? (size_t)2 * geo.ldb * 2 : (size_t)HALF * geo.ldb * 2;
  const unsigned ldsw = (unsigned)wid * 1024u;
  const int aoff = lds_byte(wr * 64 + fr, fq * 8), boff = lds_byte(wc * 32 + fr, fq * 8);
#define PG8_SA(b, h) (((b) * 2 + (h)) * HTB)
#define PG8_SB(b, h) ((4 + (b) * 2 + (h)) * HTB)
#define PG8_STAGE(bufoff, gbase, voff) do { _Pragma("unroll") for (int _i = 0; _i < 2; ++_i) \
        __builtin_amdgcn_global_load_lds((const unsigned*)((const char*)(gbase) + (voff)[_i]), (LAS unsigned*)(lds + (bufoff) + ldsw + _i * 8192), 16, 0, 0); } while (0)
#define PG8_LDA(dst, b, h) do { _Pragma("unroll") for (int m = 0; m < 4; ++m) _Pragma("unroll") for (int k = 0; k < 2; ++k) dst[m][k] = *(const LAS bf16x8*)(lds + PG8_SA(b, h) + aoff + m * 2048 + k * 1024); } while (0)
#define PG8_LDB(dst, b, h) do { _Pragma("unroll") for (int n = 0; n < 2; ++n) _Pragma("unroll") for (int k = 0; k < 2; ++k) dst[n][k] = *(const LAS bf16x8*)(lds + PG8_SB(b, h) + boff + n * 2048 + k * 1024); } while (0)
#define PG8_MMA(ai, bj, At, Bt) do { __builtin_amdgcn_s_setprio(1); _Pragma("unroll") for (int m = 0; m < 4; ++m) _Pragma("unroll") for (int n = 0; n < 2; ++n) _Pragma("unroll") for (int k = 0; k < 2; ++k) \
        acc[ai][bj][m][n] = __builtin_amdgcn_mfma_f32_16x16x32_bf16(Bt[n][k], At[m][k], acc[ai][bj][m][n], 0, 0, 0); __builtin_amdgcn_s_setprio(0); } while (0)
#define PG8_WAIT_V(n) asm volatile("s_waitcnt vmcnt(" #n ")" ::: "memory")
#define PG8_WAIT_L(n) asm volatile("s_waitcnt lgkmcnt(" #n ")" ::: "memory")
#define PG8_BAR __builtin_amdgcn_s_barrier()
#define PG8_SCHED __builtin_amdgcn_sched_barrier(0)
  Unit cur, nxt; int ui = 0;
  if (!S.next(0, cur)) return;
  f32x4 acc[2][2][4][2];
#pragma unroll
  for (int a = 0; a < 2; ++a)
#pragma unroll
    for (int b = 0; b < 2; ++b)
#pragma unroll
      for (int m = 0; m < 4; ++m)
#pragma unroll
        for (int n = 0; n < 2; ++n) acc[a][b][m][n] = (f32x4){0.f, 0.f, 0.f, 0.f};
  bf16x8 At[4][2], B0[2][2], B1[2][2];
  const char* cA = (const char*)Aop + geo.aoff(cur); const char* cB = (const char*)Bop + geo.boff(cur);
  PG8_STAGE(PG8_SB(0, 0), cB, voffB); PG8_STAGE(PG8_SB(0, 1), cB + hstepB, voffB); PG8_STAGE(PG8_SA(0, 0), cA, voffA); PG8_STAGE(PG8_SA(0, 1), cA + hstepA, voffA);
  if (wr == 1) PG8_BAR;
  PG8_WAIT_V(2); PG8_BAR;
  PG8_STAGE(PG8_SB(1, 0), cB + kstep, voffB); PG8_STAGE(PG8_SA(1, 0), cA + kstep, voffA); PG8_STAGE(PG8_SB(1, 1), cB + hstepB + kstep, voffB);
  PG8_WAIT_V(6); PG8_BAR;
  for (;;) {
    const bool has_next = S.next(ui + 1, nxt);
    const char* nA = has_next ? (const char*)Aop + geo.aoff(nxt) : cA; const char* nB = has_next ? (const char*)Bop + geo.boff(nxt) : cB;
    for (int t = 0; t < nt; t += 2) {
      const bool last = (t == nt - 2);
      const char* a1 = cA + (size_t)(t + 1) * kstep;
      const char* a2 = last ? nA : cA + (size_t)(t + 2) * kstep; const char* b2 = last ? nB : cB + (size_t)(t + 2) * kstep;
      const char* a3 = a2 + kstep; const char* b3 = b2 + kstep;
      PG8_LDB(B0, 0, 0); PG8_LDB(B1, 0, 1); PG8_SCHED; PG8_LDA(At, 0, 0); PG8_STAGE(PG8_SA(1, 1), a1 + hstepA, voffA);
      PG8_WAIT_V(8); PG8_WAIT_L(0); PG8_BAR; PG8_MMA(0, 0, At, B0); PG8_MMA(0, 1, At, B1); PG8_BAR; PG8_SCHED;
      PG8_LDA(At, 0, 1); PG8_STAGE(PG8_SB(0, 0), b2, voffB); PG8_STAGE(PG8_SB(0, 1), b2 + hstepB, voffB); PG8_STAGE(PG8_SA(0, 0), a2, voffA);
      PG8_WAIT_V(8); PG8_WAIT_L(0); PG8_BAR; PG8_MMA(1, 0, At, B0); PG8_MMA(1, 1, At, B1); PG8_BAR; PG8_SCHED;
      PG8_LDB(B0, 1, 0); PG8_LDB(B1, 1, 1); PG8_SCHED; PG8_LDA(At, 1, 0); PG8_STAGE(PG8_SA(0, 1), a2 + hstepA, voffA);
      PG8_WAIT_V(8); PG8_WAIT_L(0); PG8_BAR; PG8_MMA(0, 0, At, B0); PG8_MMA(0, 1, At, B1); PG8_BAR; PG8_SCHED;
      PG8_LDA(At, 1, 1); PG8_STAGE(PG8_SB(1, 0), b3, voffB); PG8_STAGE(PG8_SB(1, 1), b3 + hstepB, voffB); PG8_STAGE(PG8_SA(1, 0), a3, voffA);
      PG8_WAIT_V(8); PG8_WAIT_L(0); PG8_BAR; PG8_MMA(1, 0, At, B0); PG8_MMA(1, 1, At, B1); PG8_BAR; PG8_SCHED;
    }
    if (wr == 0) PG8_BAR;
    E(acc, cur, wr, wc, fr, fq);
    if (!has_next) break;
#pragma unroll
    for (int a = 0; a < 2; ++a)
#pragma unroll
      for (int b = 0; b < 2; ++b)
#pragma unroll
        for (int m = 0; m < 4; ++m)
#pragma unroll
          for (int n = 0; n < 2; ++n) acc[a][b][m][n] = (f32x4){0.f, 0.f, 0.f, 0.f};
    cur = nxt; cA = nA; cB = nB; ++ui;
    if (wr == 1) PG8_BAR;
  }
  PG8_WAIT_V(0);
  PG8_BAR;
#undef PG8_SA
#undef PG8_SB
#undef PG8_STAGE
#undef PG8_LDA
#undef PG8_LDB
#undef PG8_MMA
#undef PG8_WAIT_V
#undef PG8_WAIT_L
#undef PG8_BAR
#undef PG8_SCHED
}
}

namespace att {
constexpr int NW = 8, QBLK = 32, KVBLK = 64;
constexpr float SCALE = 0.07216878364870322f;
constexpr float THR = 8.f;
constexpr int SDEPTH = 1;
constexpr int LDQ = 3072, LDK = 2048, LDKP = 64, LDO = 2048;
constexpr int SHM_V = 16384, SHM_K = 16384, SHM_KP = 8192;
constexpr int OFF_V = 0, OFF_K = 2 * SHM_V, OFF_KP = OFF_K + 2 * SHM_K, OFF_WS = OFF_KP + 2 * SHM_KP, OFF_QP = OFF_WS + NW * 64 * 4, QP_WAVE = 32 * 208, SHM_ATTN = OFF_QP + NW * QP_WAVE;
#define KSWZ(row, colB) ((row) * 256 + ((colB) ^ (((row) & 7) << 4)))
#define KPSWZ(row, colB) ((row) * 128 + ((colB) ^ (((row) & 7) << 4)))
#define SBAR() __builtin_amdgcn_sched_barrier(0)
__device__ __forceinline__ int crow(int r, int hi) { return (r & 3) + 8 * (r >> 2) + 4 * hi; }
__device__ __forceinline__ void partialSM(f32x16& p0, f32x16& p1, float& m_reg, float& mn, float& alpha) {
  constexpr float C = SCALE * 1.4426950408889634f;
  float pmax = p0[0];
#pragma unroll
  for (int r = 1; r < 16; ++r) pmax = fmaxf(pmax, p0[r]);
#pragma unroll
  for (int r = 0; r < 16; ++r) pmax = fmaxf(pmax, p1[r]);
  { auto rr = __builtin_amdgcn_permlane32_swap(__float_as_uint(pmax), __float_as_uint(pmax), false, false);
    pmax = fmaxf(__uint_as_float(rr[0]), __uint_as_float(rr[1])); }
  if (__builtin_expect(__all(pmax - m_reg <= THR / SCALE), 1)) { mn = m_reg; alpha = 1.f; }
  else { mn = fmaxf(m_reg, pmax); alpha = __builtin_amdgcn_exp2f((m_reg - mn) * C); m_reg = mn; }
  float mnC = -mn * C;
#pragma unroll
  for (int r = 0; r < 16; ++r) p0[r] = fmaf(p0[r], C, mnC);
#pragma unroll
  for (int r = 0; r < 16; ++r) p1[r] = fmaf(p1[r], C, mnC);
#pragma unroll
  for (int r = 0; r < 16; ++r) p0[r] = __builtin_amdgcn_exp2f(p0[r]);
}
__device__ __forceinline__ void finishSM(f32x16& p0, f32x16& p1, float alpha, float& l_reg, bf16x8& pa0, bf16x8& pa1, bf16x8& pa2, bf16x8& pa3) {
#pragma unroll
  for (int r = 0; r < 16; ++r) p1[r] = __builtin_amdgcn_exp2f(p1[r]);
  float ps = 0;
#pragma unroll
  for (int r = 0; r < 16; ++r) ps += p0[r];
#pragma unroll
  for (int r = 0; r < 16; ++r) ps += p1[r];
  { auto rr = __builtin_amdgcn_permlane32_swap(__float_as_uint(ps), __float_as_uint(ps), false, false);
    ps = __uint_as_float(rr[0]) + __uint_as_float(rr[1]); }
  l_reg = l_reg * alpha + ps;
#define PK4(P, BASE, OUT) do { unsigned a0 = cvt_pk(P[BASE + 0], P[BASE + 1]), a1 = cvt_pk(P[BASE + 2], P[BASE + 3]);   \
    unsigned b0 = cvt_pk(P[BASE + 4], P[BASE + 5]), b1 = cvt_pk(P[BASE + 6], P[BASE + 7]);                              \
    auto r0 = __builtin_amdgcn_permlane32_swap(a0, b0, false, false); auto r1 = __builtin_amdgcn_permlane32_swap(a1, b1, false, false); \
    u32x4 w = {r0[0], r1[0], r0[1], r1[1]}; OUT = *reinterpret_cast<bf16x8*>(&w); } while (0)
  PK4(p0, 0, pa0); PK4(p0, 8, pa1); PK4(p1, 0, pa2); PK4(p1, 8, pa3);
#undef PK4
}
__device__ __forceinline__ void qkt(f32x16& p0, f32x16& p1, const char* Ks, const char* KPs, const char* QPs, const bf16x8* qr, int r32, int hi) {
  p0 = f32x16{}; p1 = f32x16{};
  const char* qrow = QPs + r32 * 208 + hi * 16;
#pragma unroll
  for (int d0 = 0; d0 < 8; ++d0) { int cb = (d0 * 16 + hi * 8) * 2;
    bf16x8 b0 = *reinterpret_cast<const bf16x8*>(Ks + KSWZ(r32, cb));
    bf16x8 b1 = *reinterpret_cast<const bf16x8*>(Ks + KSWZ(32 + r32, cb));
    bf16x8 qf; if (d0 < 6) qf = qr[d0]; else qf = *reinterpret_cast<const bf16x8*>(qrow + (d0 - 6) * 32);
    p0 = __builtin_amdgcn_mfma_f32_32x32x16_bf16(b0, qf, p0, 0, 0, 0);
    p1 = __builtin_amdgcn_mfma_f32_32x32x16_bf16(b1, qf, p1, 0, 0, 0); }
#pragma unroll
  for (int d0 = 0; d0 < 4; ++d0) { int cb = (d0 * 16 + hi * 8) * 2;
    bf16x8 b0 = *reinterpret_cast<const bf16x8*>(KPs + KPSWZ(r32, cb));
    bf16x8 b1 = *reinterpret_cast<const bf16x8*>(KPs + KPSWZ(32 + r32, cb));
    bf16x8 qf = *reinterpret_cast<const bf16x8*>(qrow + (d0 + 2) * 32);
    p0 = __builtin_amdgcn_mfma_f32_32x32x16_bf16(b0, qf, p0, 0, 0, 0);
    p1 = __builtin_amdgcn_mfma_f32_32x32x16_bf16(b1, qf, p1, 0, 0, 0); }
}
__device__ __forceinline__ int v_st(int k, int c) { const int kk = (k & ~0xC) | ((k & 4) << 1) | ((k & 8) >> 1); return ((kk >> 3) * 4 + (c >> 5)) * 512 + ((kk & 7) * 32 + (c & 31)) * 2; }
__device__ __forceinline__ int v_rd_base(int lane) { return ((lane & 3) << 3) | (((lane >> 2) & 3) << 6) | (((lane >> 4) & 1) << 5) | (((lane >> 5) & 1) << 8); }
constexpr int v_rd_off(int d0, int ks, int half) { return d0 * 512 + ks * 4096 + half * 2048; }
template <int OFF> __device__ __forceinline__ s16x4 tr_read(int vb) {
  s16x4 r; asm volatile("ds_read_b64_tr_b16 %0, %1 offset:%2" : "=&v"(r) : "v"(vb), "i"(OFF) : "memory"); return r;
}
#define PV_READ(D0, KH, L, H) do { L[0] = tr_read<v_rd_off(D0, 2 * KH, 0)>(vb); H[0] = tr_read<v_rd_off(D0, 2 * KH, 1)>(vb); L[1] = tr_read<v_rd_off(D0, 2 * KH + 1, 0)>(vb); H[1] = tr_read<v_rd_off(D0, 2 * KH + 1, 1)>(vb); } while (0)
#define PV_PK(L, H) (bf16x8){L[0], L[1], L[2], L[3], H[0], H[1], H[2], H[3]}
#define PV_MMA(OD, PX, PY, L, H) do { OD = __builtin_amdgcn_mfma_f32_32x32x16_bf16(PX, PV_PK(L[0], H[0]), OD, 0, 0, 0); OD = __builtin_amdgcn_mfma_f32_32x32x16_bf16(PY, PV_PK(L[1], H[1]), OD, 0, 0, 0); } while (0)
#define PV_W4() do { asm volatile("s_waitcnt lgkmcnt(4)" ::: "memory"); SBAR(); } while (0)
__device__ __forceinline__ void pv_d0(f32x16* o, int vb, bf16x8 pa0, bf16x8 pa1, bf16x8 pa2, bf16x8 pa3) {
  s16x4 la[2], ha[2], lb[2], hb[2];
  PV_READ(0, 0, la, ha);
  PV_READ(0, 1, lb, hb); PV_W4(); PV_MMA(o[0], pa0, pa1, la, ha); SBAR();
  PV_READ(1, 0, la, ha); PV_W4(); PV_MMA(o[0], pa2, pa3, lb, hb); SBAR();
  PV_READ(1, 1, lb, hb); PV_W4(); PV_MMA(o[1], pa0, pa1, la, ha); SBAR();
  PV_READ(2, 0, la, ha); PV_W4(); PV_MMA(o[1], pa2, pa3, lb, hb); SBAR();
  PV_READ(2, 1, lb, hb); PV_W4(); PV_MMA(o[2], pa0, pa1, la, ha); SBAR();
  PV_READ(3, 0, la, ha); PV_W4(); PV_MMA(o[2], pa2, pa3, lb, hb); SBAR();
  PV_READ(3, 1, lb, hb); PV_W4(); PV_MMA(o[3], pa0, pa1, la, ha); SBAR();
  asm volatile("s_waitcnt lgkmcnt(0)" ::: "memory"); SBAR(); PV_MMA(o[3], pa2, pa3, lb, hb);
}
#undef PV_READ
#undef PV_W4
__device__ __forceinline__ void attn_body(const bf16_t* __restrict__ Qb, const bf16_t* __restrict__ Kh, const bf16_t* __restrict__ KPh, const bf16_t* __restrict__ Vh,
                                          bf16_t* __restrict__ Ob, int seq, char* lds) {
  const int tid = opaque(threadIdx.x), wid = tid >> 6, lane = tid & 63, r32 = lane & 31, hi = lane >> 5;
  char* V_lds = lds + OFF_V; char* K_lds = lds + OFF_K; char* KP_lds = lds + OFF_KP;
  float* ws = (float*)(lds + OFF_WS) + wid * 64; float* li_l = ws; float* al_l = ws + 32;
  float m_reg = -1e30f, l_reg = 0; f32x16 o[4] = {}; bf16x8 qr[6];
  char* QP_lds = lds + OFF_QP + wid * QP_WAVE;
  const bf16_t* Qw = Qb + (long)(wid * QBLK + r32) * LDQ + hi * 8;
#pragma unroll
  for (int d0 = 0; d0 < 6; ++d0) qr[d0] = *reinterpret_cast<const bf16x8*>(Qw + d0 * 16);
#pragma unroll
  for (int d0 = 6; d0 < 12; ++d0) *reinterpret_cast<bf16x8*>(QP_lds + r32 * 208 + hi * 16 + (d0 - 6) * 32) = *reinterpret_cast<const bf16x8*>(Qw + d0 * 16);
  const int sr = tid >> 4, sc = (tid & 15) * 8, vst0 = v_st(sr, sc), vst1 = v_st(32 + sr, sc);
  const int pr = tid >> 3, pc = (tid & 7) * 8;
  const int vb0 = (int)(uintptr_t)V_lds + v_rd_base(lane);
  struct { bf16x8 vs0, vs1, ks0, ks1, kp; } sr_[SDEPTH];
#define SLOAD(i, k0) do { sr_[i].vs0 = *reinterpret_cast<const bf16x8*>(&Vh[(long)((k0) + sr) * LDK + sc]); sr_[i].vs1 = *reinterpret_cast<const bf16x8*>(&Vh[(long)((k0) + 32 + sr) * LDK + sc]); \
    sr_[i].ks0 = *reinterpret_cast<const bf16x8*>(&Kh[(long)((k0) + sr) * LDK + sc]); sr_[i].ks1 = *reinterpret_cast<const bf16x8*>(&Kh[(long)((k0) + 32 + sr) * LDK + sc]); \
    sr_[i].kp = *reinterpret_cast<const bf16x8*>(&KPh[(long)((k0) + pr) * LDKP + pc]); } while (0)
#define SWRITE(b, i) do { *(bf16x8*)(V_lds + (b) * SHM_V + vst0) = sr_[i].vs0;          \
    *(bf16x8*)(V_lds + (b) * SHM_V + vst1) = sr_[i].vs1; int kc = sc * 2;               \
    *(bf16x8*)(K_lds + (b) * SHM_K + KSWZ(sr, kc)) = sr_[i].ks0;                       \
    *(bf16x8*)(K_lds + (b) * SHM_K + KSWZ(32 + sr, kc)) = sr_[i].ks1;                  \
    *(bf16x8*)(KP_lds + (b) * SHM_KP + KPSWZ(pr, pc * 2)) = sr_[i].kp; } while (0)
#define SWAIT() do { if constexpr (SDEPTH == 2) asm volatile("s_waitcnt vmcnt(5)" ::: "memory"); else asm volatile("s_waitcnt vmcnt(0)" ::: "memory"); } while (0)
#define RESC(a) do { if (__any((a) < 1.f)) { if (hi == 0) al_l[r32] = (a); asm volatile("s_waitcnt lgkmcnt(0)" ::: "memory"); \
    _Pragma("unroll") for (int d = 0; d < 4; ++d) _Pragma("unroll") for (int r = 0; r < 16; ++r) o[d][r] *= al_l[crow(r, hi)]; } } while (0)
  f32x16 pA0, pA1, pB0, pB1; float mnA, mnB, alA, alB; bf16x8 pa0, pa1, pa2, pa3; const int NT = seq / KVBLK;
  constexpr int SE = 0, SO = SDEPTH - 1;
  SLOAD(SE, 0); asm volatile("s_waitcnt vmcnt(0)" ::: "memory"); SWRITE(0, SE); __syncthreads();
  qkt(pA0, pA1, K_lds, KP_lds, QP_lds, qr, r32, hi); partialSM(pA0, pA1, m_reg, mnA, alA);
  SLOAD(SO, KVBLK); if constexpr (SDEPTH == 2) { if (2 < NT) SLOAD(SE, 2 * KVBLK); }
  SWAIT(); SWRITE(1, SO); __syncthreads();
  for (int j = 1; j + 1 < NT; j += 2) {
    SBAR(); qkt(pB0, pB1, K_lds + SHM_K, KP_lds + SHM_KP, QP_lds, qr, r32, hi);
    finishSM(pA0, pA1, alA, l_reg, pa0, pa1, pa2, pa3); SBAR();
    SLOAD(SO, (j + SDEPTH) * KVBLK); SBAR();
    pv_d0(o, vb0, pa0, pa1, pa2, pa3); partialSM(pB0, pB1, m_reg, mnB, alB);
    __syncthreads(); SWAIT(); SWRITE(0, SE);
    RESC(alB); __syncthreads();
    SBAR(); qkt(pA0, pA1, K_lds, KP_lds, QP_lds, qr, r32, hi);
    finishSM(pB0, pB1, alB, l_reg, pa0, pa1, pa2, pa3); SBAR();
    if (SDEPTH == 1 || j + 3 < NT) SLOAD(SE, (j + 1 + SDEPTH) * KVBLK); SBAR();
    pv_d0(o, vb0 + SHM_V, pa0, pa1, pa2, pa3); partialSM(pA0, pA1, m_reg, mnA, alA);
    __syncthreads(); SWAIT(); SWRITE(1, SO);
    RESC(alA); __syncthreads();
  }
  SBAR(); qkt(pB0, pB1, K_lds + SHM_K, KP_lds + SHM_KP, QP_lds, qr, r32, hi);
  finishSM(pA0, pA1, alA, l_reg, pa0, pa1, pa2, pa3); SBAR();
  pv_d0(o, vb0, pa0, pa1, pa2, pa3); partialSM(pB0, pB1, m_reg, mnB, alB);
  __syncthreads(); RESC(alB);
  finishSM(pB0, pB1, alB, l_reg, pa0, pa1, pa2, pa3); SBAR();
  pv_d0(o, vb0 + SHM_V, pa0, pa1, pa2, pa3);
  if (hi == 0) li_l[r32] = l_reg; asm volatile("s_waitcnt lgkmcnt(0)" ::: "memory");
  float rli[16];
#pragma unroll
  for (int r = 0; r < 16; ++r) rli[r] = __builtin_amdgcn_rcpf(li_l[crow(r, hi)]);
  bf16_t* Ow = Ob + (long)(wid * QBLK) * LDO;
#pragma unroll
  for (int r = 0; r < 16; ++r) { int orow = crow(r, hi);
#pragma unroll
    for (int d0 = 0; d0 < 4; ++d0) Ow[(long)orow * LDO + d0 * 32 + r32] = (bf16_t)(cvt_pk(o[d0][r] * rli[r], 0.f) & 0xffffu); }
  __syncthreads();
#undef SLOAD
#undef SWRITE
#undef SWAIT
#undef RESC
}
#undef SBAR
}

struct Ctx { int tid, lane, wave, G, bx, vcu; char* lds; };

__device__ __forceinline__ void phase_mods(const Params& p, const Ctx& c_in) {
  Ctx c = c_in; c.tid = opaque(c_in.tid); c.lane = c.tid & 63; c.wave = __builtin_amdgcn_readfirstlane(c.tid >> 6);
  float* sl = (float*)c.lds;
  float* red = sl + 5 * 2048;
  for (int i = c.tid; i < 5 * 2048; i += 512) { const int r = i >> 11, k = i & 2047; const float v = r < 4 ? p.c[r * 2048 + k] : p.c_ctx[k]; sl[i] = v * fsigmoid(v); }
  __syncthreads();
  float* mods = (float*)(p.ws + WS_MODS);
  for (int ch = c.bx; ch < 256; ch += c.G) {
    const int l = ch >> 7, n0 = (ch & 127) * 96;
    const int cgp = c.tid % 24, ks = c.tid / 24;
    float a[5][4];
#pragma unroll
    for (int r = 0; r < 5; ++r)
#pragma unroll
      for (int j = 0; j < 4; ++j) a[r][j] = 0.f;
    if (c.tid < 384) {
      const float* W = p.ada_w + (size_t)l * 2048 * 12288 + n0 + 4 * cgp;
      for (int k = ks; k < 2048; k += 16) { const f32x4 w = *(const f32x4*)(W + (size_t)k * 12288);
#pragma unroll
        for (int r = 0; r < 5; ++r) { const float s = sl[r * 2048 + k];
#pragma unroll
          for (int j = 0; j < 4; ++j) a[r][j] += s * w[j]; } }
#pragma unroll
      for (int r = 0; r < 5; ++r)
#pragma unroll
        for (int j = 0; j < 4; ++j) red[(ks * 24 + cgp) * 20 + r * 4 + j] = a[r][j];
    }
    __syncthreads();
    if (c.tid < 480) { const int r = c.tid / 96, n = c.tid % 96, cg2 = n >> 2, j = n & 3; float s = 0.f;
      for (int q = 0; q < 16; ++q) s += red[(q * 24 + cg2) * 20 + r * 4 + j];
      mods[((size_t)l * 5 + r) * 12288 + n0 + n] = s + p.ada_b[l * 12288 + n0 + n]; }
    __syncthreads();
  }
}
__device__ __forceinline__ void phase_tables(const Params& p, const Ctx& c_in) {
  Ctx c = c_in; c.tid = opaque(c_in.tid); c.lane = c.tid & 63; c.wave = __builtin_amdgcn_readfirstlane(c.tid >> 6);
  float* T = (float*)c.lds;
  for (int i = c.tid; i < 4096; i += 512) T[i] = cosf((float)i * (6.283185307179586f / 4096.f)) * (1.f / 64.f);
  __syncthreads();
  const long gt = (long)c.bx * 512 + c.tid, GT = (long)c.G * 512;
  float* rc = (float*)(p.ws + WS_ROPEC); float* rs = (float*)(p.ws + WS_ROPES);
  for (long i = gt; i < 4096 * 32; i += GT) { const int pos = (int)(i >> 5), f = (int)(i & 31);
    const float inv = powf(10000.f, -(float)(f & 15) / 16.f); const float ang = (float)(f < 16 ? (pos >> 6) : (pos & 63)) * inv;
    rc[i] = cosf(ang); rs[i] = sinf(ang); }
  { bf16_t* fa = (bf16_t*)(p.ws + WS_FFTA); bf16_t* fc = (bf16_t*)(p.ws + WS_FFTC); float* twc = (float*)(p.ws + WS_TWC); float* tws = (float*)(p.ws + WS_TWS);
    for (long i = gt; i < 256 * 128; i += GT) { const int rho = (int)(i >> 7), kap = (int)(i & 127), cc = kap >> 6, nn = kap & 63;
      float va = 0.f, vc = 0.f;
      if (rho < 128) { const int wr_ = rho >> 6, m_ = (rho >> 4) & 3, fr_ = rho & 15, k1 = 32 * wr_ + 16 * (m_ & 1) + fr_, isim = m_ >> 1, r = (k1 * nn) & 63;
        const float cs_ = T[(64 * r) & 4095] * 8.f, sn_ = T[(64 * r + 3072) & 4095] * 8.f;
        va = isim ? (cc ? -cs_ : -sn_) : (cc ? -sn_ : cs_); }
      if (rho < 64) { const int r = (rho * nn) & 63; vc = cc ? T[(64 * r + 3072) & 4095] * 8.f : T[(64 * r) & 4095] * 8.f; }
      fa[i] = (bf16_t)(cvt_pk(va, 0.f) & 0xffffu); fc[i] = (bf16_t)(cvt_pk(vc, 0.f) & 0xffffu); }
    for (long i = gt; i < 64 * 64; i += GT) { const int k1 = (int)(i >> 6), n2 = (int)(i & 63), r = k1 * n2; twc[i] = T[r & 4095] * 64.f; tws[i] = T[(r + 3072) & 4095] * 64.f; } }
  bf16_t* dc = (bf16_t*)(p.ws + WS_DFTC);
  for (long i = gt; i < 256 * 512; i += GT) { const int m = (int)(i >> 9), kk = (int)(i & 511), n = kk & 255, s = kk >> 8;
    dc[i] = (bf16_t)(cvt_pk(T[(((m * n + 64 * s) & 255) * 16) & 4095] * 4.f, 0.f) & 0xffffu); }
  bf16_t* cs = (bf16_t*)(p.ws + WS_CS1);
  for (long i = gt; i < 256 * 128; i += GT) { const int jp = (int)(i >> 7), j = (int)(i & 127), l = jp & 127, s = jp >> 7;
    cs[i] = (bf16_t)(cvt_pk(T[(((l * j) & 127) * 32 + 3072 * s) & 4095] * 5.656854249492381f, 0.f) & 0xffffu); }
  __syncthreads();
}

enum { J_IN = 0, J_F, J_C, J_UQ, J_UKV, J_MLA, J_OUT, J_GU, J_DN, J_NUM };
struct WJob { const float* src; const float* src2; const float* gain; bf16_t* dst; int K, Nd, ldn, kind; };
__device__ __forceinline__ const float* wsrc(const WJob& j, int n0) {
  const int tile = n0 >> 8, r = n0 & 255;
  switch (j.kind) {
    case J_IN:
      if (tile < 4) return j.src + n0;
      if (tile < 12) { const int t = tile - 4; return j.src + (r < 128 ? F_END + 128 * t + r : F_END + 1024 + 128 * t + (r - 128)); }
      if (tile < 15) return j.src + C_END + (n0 - 12 * 256);
      if (tile < 17) return j.src + Q_END + (n0 - 15 * 256);
      if (tile == 17) return r == 0 ? j.src + KV_END : (r == 128 ? j.src + KV_END + 32 : nullptr);
      return j.src + KPE_END + (n0 - 18 * 256);
    case J_UQ:
      if (tile < 8) return j.src + (n0 >> 7) * 192 + (n0 & 127);
      { const int t = tile - 8, bj = r >> 7, wc = (r >> 5) & 3; return j.src + (4 * t + wc) * 192 + 128 + bj * 32; }
    case J_UKV:
      if (tile < 8) return j.src + (n0 >> 7) * 256 + (n0 & 127);
      { const int n1 = n0 - 2048; return j.src + (n1 >> 7) * 256 + 128 + (n1 & 127); }
    case J_GU:
      return (r < 128 ? j.src : j.src2) + 128 * tile + (r & 127);
    default: return j.src + n0;
  }
}
__device__ __forceinline__ void transpose_item(const WJob& j, int item, LAS float* scr, int lane) {
  const int nblk = j.Nd / 64, kb = item / nblk, nb = item % nblk, k0 = 64 * kb, n0 = 64 * nb;
  const int col4 = (lane & 15) * 4;
  const float* s = wsrc(j, n0 + (col4 & 32));
  f32x4 v[16];
#pragma unroll
  for (int i = 0; i < 16; ++i) { const int kk = 4 * i + (lane >> 4); v[i] = (f32x4){0.f, 0.f, 0.f, 0.f};
    if (s) { v[i] = *(const f32x4*)(s + (size_t)(k0 + kk) * j.ldn + (col4 & 31)); if (j.gain) v[i] = v[i] * j.gain[k0 + kk]; } }
#pragma unroll
  for (int i = 0; i < 16; ++i) { const int kk = 4 * i + (lane >> 4);
#pragma unroll
    for (int e = 0; e < 4; ++e) scr[kk * 65 + col4 + e] = v[i][e]; }
  asm volatile("s_waitcnt lgkmcnt(0)" ::: "memory");
  const int cch = lane & 7;
#pragma unroll
  for (int q = 0; q < 8; ++q) { const int n = (lane >> 3) + 8 * q; const LAS float* t = scr + (8 * cch) * 65 + n;
    u32x4 o; o.x = cvt_pk(t[0 * 65], t[1 * 65]); o.y = cvt_pk(t[2 * 65], t[3 * 65]); o.z = cvt_pk(t[4 * 65], t[5 * 65]); o.w = cvt_pk(t[6 * 65], t[7 * 65]);
    *(u32x4*)(j.dst + (size_t)(n0 + n) * j.K + k0 + 8 * cch) = o; }
  asm volatile("s_waitcnt lgkmcnt(0)" ::: "memory");
}
__device__ __forceinline__ void phase_wconv(const Params& p, const Ctx& c_in, int l) {
  Ctx c = c_in; c.tid = opaque(c_in.tid); c.lane = c.tid & 63; c.wave = __builtin_amdgcn_readfirstlane(c.tid >> 6);
  LAS float* scr = (LAS float*)((LAS unsigned char*)c.lds + c.wave * 16640);
  const int gw = c.vcu * 8 + c.wave, NGW = c.G * 8;
  unsigned char* ws = p.ws;
#pragma unroll 1
  for (int jk = 0; jk < J_NUM; ++jk) {
    WJob j; j.src2 = nullptr; j.gain = nullptr; j.kind = jk;
    switch (jk) {
      case J_IN: j.src = p.w_in + (size_t)l * 2048 * IN_COLS; j.dst = (bf16_t*)(ws + WS_WIN); j.K = 2048; j.Nd = 10752; j.ldn = IN_COLS; break;
      case J_F: j.src = p.w_fourier + (size_t)l * 1024 * 2048; j.dst = (bf16_t*)(ws + WS_WF); j.K = 1024; j.Nd = 2048; j.ldn = 2048; break;
      case J_C: j.src = p.w_conv_out + (size_t)l * 1024 * 2048; j.dst = (bf16_t*)(ws + WS_WC); j.K = 1024; j.Nd = 2048; j.ldn = 2048; break;
      case J_UQ: j.src = p.w_uq + (size_t)l * 768 * 3072; j.gain = p.q_norm_g + l * 768; j.dst = (bf16_t*)(ws + WS_WUQ); j.K = 768; j.Nd = 3072; j.ldn = 3072; break;
      case J_UKV: j.src = p.w_ukv + (size_t)l * 512 * 4096; j.gain = p.kv_norm_g + l * 512; j.dst = (bf16_t*)(ws + WS_WUKV); j.K = 512; j.Nd = 4096; j.ldn = 4096; break;
      case J_MLA: j.src = p.w_mla_o + (size_t)l * 2048 * 2048; j.dst = (bf16_t*)(ws + WS_WMLA); j.K = 2048; j.Nd = 2048; j.ldn = 2048; break;
      case J_OUT: j.src = p.w_out + (size_t)l * 2048 * 2048; j.dst = (bf16_t*)(ws + WS_WOUT); j.K = 2048; j.Nd = 2048; j.ldn = 2048; break;
      case J_GU: j.src = p.w_ffn_gate + (size_t)l * 2048 * FFH; j.src2 = p.w_ffn_up + (size_t)l * 2048 * FFH; j.dst = (bf16_t*)(ws + WS_WGU); j.K = 2048; j.Nd = 2 * FFH; j.ldn = FFH; break;
      default: j.src = p.w_ffn_down + (size_t)l * FFH * 2048; j.dst = (bf16_t*)(ws + WS_WDN); j.K = FFH; j.Nd = 2048; j.ldn = 2048; break;
    }
    const int nitems = (j.K / 64) * (j.Nd / 64);
    for (int it = gw; it < nitems; it += NGW) transpose_item(j, it, scr, c.lane);
  }
}
__device__ __forceinline__ void phase_normmod(const Params& p, const Ctx& c_in, const float* xl, const float* xc, const float* gain, const float* mods_l, int sh_idx, int nrows, bf16_t* hout,
                                              const float* part, const float* pgate, float* xstore) {
  Ctx c = c_in; c.tid = opaque(c_in.tid); c.lane = c.tid & 63; c.wave = __builtin_amdgcn_readfirstlane(c.tid >> 6);
  const int gw = c.vcu * 8 + c.wave, NGW = c.G * 8;
  for (int row = gw; row < nrows; row += NGW) {
    const float* xr = row < MX ? xl + (size_t)row * 2048 : xc + (size_t)(row - MX) * 2048;
    const float* md = mods_l + modgrp(row) * 12288;
    f32x4 v[8]; float ss = 0.f;
#pragma unroll
    for (int q = 0; q < 8; ++q) { const int col = q * 256 + c.lane * 4; v[q] = *(const f32x4*)(xr + col);
      if (part && row >= MX) { const float* pr = part + (size_t)(row - MX) * 2048 + col; const size_t ps = (size_t)1024 * 2048;
        const f32x4 sum = (*(const f32x4*)pr + *(const f32x4*)(pr + ps)) + (*(const f32x4*)(pr + 2 * ps) + *(const f32x4*)(pr + 3 * ps));
        v[q] = v[q] + *(const f32x4*)(pgate + col) * sum; if (xstore) *(f32x4*)(xstore + (size_t)(row - MX) * 2048 + col) = v[q]; }
      ss += (v[q][0] * v[q][0] + v[q][1] * v[q][1]) + (v[q][2] * v[q][2] + v[q][3] * v[q][3]); }
    const float rstd = 1.0f / sqrtf(wave_sum(ss) * (1.f / 2048.f) + EPS);
#pragma unroll
    for (int q = 0; q < 8; ++q) { const int col = q * 256 + c.lane * 4; const f32x4 g = *(const f32x4*)(gain + col), sh = *(const f32x4*)(md + sh_idx * 2048 + col), sc = *(const f32x4*)(md + (sh_idx + 1) * 2048 + col);
      const f32x4 y = v[q] * rstd * g * (sc + 1.f) + sh; u32x2 w; w.x = cvt_pk(y[0], y[1]); w.y = cvt_pk(y[2], y[3]);
      *(u32x2*)(hout + (size_t)row * 2048 + col) = w; }
  }
}
__device__ __forceinline__ void phase_conv(const Params& p, const Ctx& c_in, int l, int nrows, int cidx) {
  Ctx c = c_in; c.tid = opaque(c_in.tid); c.lane = c.tid & 63; c.wave = __builtin_amdgcn_readfirstlane(c.tid >> 6);
  constexpr int TT = 16, HALO = 15, NR = TT + 2 * HALO;
  const bf16_t* vb = (const bf16_t*)(p.ws + WS_VB); bf16_t* ob = (bf16_t*)(p.ws + WS_CBF);
  unsigned* tile = (unsigned*)c.lds;
  f32x2* red = (f32x2*)(c.lds + NR * 2048);
  const int ch = 2 * c.tid;
  float w0[31], w1[31];
#pragma unroll
  for (int k = 0; k < 31; ++k) { const f32x2 w = *(const f32x2*)(p.conv_w + ((size_t)l * 31 + k) * 1024 + ch); w0[k] = w[0]; w1[k] = w[1]; }
  const f32x2 cb = *(const f32x2*)(p.conv_b + l * 1024 + ch), lg = *(const f32x2*)(p.conv_ln_g + l * 1024 + ch), lb = *(const f32x2*)(p.conv_ln_b + l * 1024 + ch);
  const int ntiles = nrows / TT;
  for (int t = cidx; t < ntiles; t += c.G) {
    const int r0 = t * TT; const int seqlen = r0 < MX ? SEQ : CTXL; const int sbeg = r0 < MX ? (r0 & ~(SEQ - 1)) : MX + ((r0 - MX) & ~(CTXL - 1)); const int send = sbeg + seqlen;
    for (int i = c.tid; i < NR * 128; i += 512) { const int rr = i >> 7, cc = i & 127, row = r0 - HALO + rr; u32x4 v = {0u, 0u, 0u, 0u};
      if (row >= sbeg && row < send) v = *(const u32x4*)(vb + (size_t)row * 1024 + cc * 8);
      *(u32x4*)(tile + rr * 512 + cc * 4) = v; }
    __syncthreads();
    float y0[TT], y1[TT];
#pragma unroll
    for (int tt = 0; tt < TT; ++tt) { float a0 = cb[0], a1 = cb[1];
#pragma unroll
      for (int k = 0; k < 31; ++k) { const unsigned w = tile[(tt + k) * 512 + c.tid]; a0 += bflo(w) * w0[k]; a1 += bfhi(w) * w1[k]; }
      y0[tt] = a0; y1[tt] = a1;
      const float s = wave_sum(a0 + a1), q = wave_sum(a0 * a0 + a1 * a1);
      if (c.lane == 0) red[tt * 8 + c.wave] = (f32x2){s, q}; }
    __syncthreads();
#pragma unroll
    for (int tt = 0; tt < TT; ++tt) { float s = 0.f, q = 0.f;
#pragma unroll
      for (int w = 0; w < 8; ++w) { const f32x2 r = red[tt * 8 + w]; s += r[0]; q += r[1]; }
      const float mu = s * (1.f / 1024.f); const float var = fmaxf(q * (1.f / 1024.f) - mu * mu, 0.f); const float rstd = 1.0f / sqrtf(var + EPS);
      float z0 = (y0[tt] - mu) * rstd * lg[0] + lb[0], z1 = (y1[tt] - mu) * rstd * lg[1] + lb[1];
      z0 = z0 * fsigmoid(z0); z1 = z1 * fsigmoid(z1);
      *(unsigned*)(ob + (size_t)(r0 + tt) * 1024 + ch) = cvt_pk(z0, z1); }
    __syncthreads();
  }
}
__device__ __forceinline__ void phase_final(const Params& p, const Ctx& c_in) {
  Ctx c = c_in; c.tid = opaque(c_in.tid); c.lane = c.tid & 63; c.wave = __builtin_amdgcn_readfirstlane(c.tid >> 6);
  const int gw = c.vcu * 8 + c.wave, NGW = c.G * 8;
  for (int row = gw; row < MX; row += NGW) { float* xr = p.out + (size_t)row * 2048; f32x4 v[8]; float ss = 0.f;
#pragma unroll
    for (int q = 0; q < 8; ++q) { v[q] = *(const f32x4*)(xr + q * 256 + c.lane * 4); ss += (v[q][0] * v[q][0] + v[q][1] * v[q][1]) + (v[q][2] * v[q][2] + v[q][3] * v[q][3]); }
    const float rstd = 1.0f / sqrtf(wave_sum(ss) * (1.f / 2048.f) + EPS);
#pragma unroll
    for (int q = 0; q < 8; ++q) { const int col = q * 256 + c.lane * 4; *(f32x4*)(xr + col) = v[q] * rstd * *(const f32x4*)(p.final_norm_g + col); } }
}

constexpr int LDS_BYTES = 147456;
__device__ __forceinline__ void grid_barrier(unsigned char* ws, volatile LAS unsigned* nbar_lds) {
  asm volatile("s_waitcnt vmcnt(0) lgkmcnt(0)" ::: "memory");
  __syncthreads();
  if (threadIdx.x == 0) {
    unsigned* bar = (unsigned*)(ws + WS_FLAGS); const unsigned G = gridDim.x, nbar = *nbar_lds;
    __builtin_amdgcn_fence(__ATOMIC_RELEASE, "agent"); asm volatile("s_waitcnt vmcnt(0)" ::: "memory");
    const unsigned old = __hip_atomic_fetch_add(bar, 1u, __ATOMIC_RELAXED, __HIP_MEMORY_SCOPE_AGENT);
    if (old + 1u == G * (nbar + 1u)) __hip_atomic_store(bar + 64, nbar + 1u, __ATOMIC_RELAXED, __HIP_MEMORY_SCOPE_AGENT);
    else while (__hip_atomic_load(bar + 64, __ATOMIC_RELAXED, __HIP_MEMORY_SCOPE_AGENT) <= nbar) __builtin_amdgcn_s_sleep(2);
    __builtin_amdgcn_fence(__ATOMIC_ACQUIRE, "agent"); asm volatile("s_waitcnt vmcnt(0)" ::: "memory");
    *nbar_lds = nbar + 1u;
  }
  __syncthreads();
}
enum { SK_NONE = 0, SK_GEMM, SK_P0, SK_CONV, SK_ATT, SK_NORM2, SK_CMERGE };
constexpr int NSTEP = 31;
__device__ __forceinline__ Params load_params() { KArgP ka = kargs(); Params P; __builtin_memcpy(&P, (const void*)ka, sizeof(Params)); return P; }
__global__ void __launch_bounds__(512, 2) mk_fwd(Params p_unused) {
  extern __shared__ __attribute__((aligned(16))) unsigned char lds_raw[];
  cg::grid_group grid = cg::this_grid();
  Ctx c; c.tid = threadIdx.x; c.lane = c.tid & 63; c.wave = __builtin_amdgcn_readfirstlane(c.tid >> 6); c.G = gridDim.x; c.bx = blockIdx.x;
  c.vcu = (c.G % 8 == 0) ? (c.bx % 8) * (c.G / 8) + c.bx / 8 : c.bx; c.lds = (char*)lds_raw;
  LAS unsigned char* lds3 = (LAS unsigned char*)lds_raw;
  unsigned char* ws = kargs()->ws;
  const int G = c.G;

  volatile LAS unsigned* nbar_lds = (volatile LAS unsigned*)(lds3 + LDS_BYTES - 64);
  if (c.tid == 0) *nbar_lds = 0u;
  grid.sync();
  { const Params P = load_params(); phase_mods(P, c); phase_tables(P, c); }
  grid_barrier(ws, nbar_lds);

#pragma unroll 1
  for (int l = 0; l < 2; ++l) {
    const int nM = l == 0 ? 68 : 64;
    int base = 0;
#pragma unroll 1
    for (int st = 0; st < NSTEP; ++st) {
      int kind = SK_GEMM, sync = 0, K = 2048, oM = nM, oN = 8, rot = 0;
      size_t aofs = WS_H, bofs = WS_WIN;
      pg8::Epi E{}; E.l = l; E.ws = ws; pg8::Geo g{}; g.mode = pg8::GEO_STD; g.lda = 2048; g.ldb = 2048;
      const int sx = st < 8 ? st : (st == 8 ? 100 : st - 1);
      switch (sx) {
        case 0: kind = SK_P0; sync = 1; break;
        case 1:
          E.mode = pg8::E_IN; oN = 18; sync = (l == 0); break;
        case 2:
          if (l == 0) { kind = SK_NONE; break; }
          E.mode = pg8::E_IN; E.pm_off = 64; E.pn_off = 15; aofs = WS_H + (size_t)MX * 2048 * 2; bofs = WS_WIN + (size_t)15 * 256 * 2048 * 2; oM = 4; oN = 3; rot = 64 * 18; sync = 1; break;
        case 3:
          E.mode = pg8::E_DFT1; g.mode = pg8::GEO_DFT1; g.lda = 128; g.ldb = 1024; aofs = WS_CS1; bofs = WS_UF; K = 128; oM = 1; oN = 512; base = 0; break;
        case 4:
          if (l != 0) { kind = SK_NONE; break; }
          E.mode = pg8::E_DFT1; E.aux = 1; g.mode = pg8::GEO_DFT1; g.aux = 1; g.lda = 128; g.ldb = 1024; aofs = WS_CS1; bofs = WS_UF + (size_t)MX * 1024 * 2; K = 128; oM = 1; oN = 32; rot = base; break;
        case 5:
          E.mode = pg8::E_UQ; g.lda = 768; g.ldb = 768; aofs = WS_QD; bofs = WS_WUQ; K = 768; oN = 12; rot = base; break;
        case 6:
          E.mode = pg8::E_UKV; g.lda = 512; g.ldb = 512; aofs = WS_KVD; bofs = WS_WUKV; K = 512; oM = 68; oN = 16; rot = base; break;
        case 7: kind = SK_CONV; rot = base; sync = 1; break;
        case 8: kind = SK_ATT; break;
        case 100:
          E.mode = pg8::E_FFTA; g.mode = pg8::GEO_A0; g.lda = 128; g.ldb = 128; aofs = WS_FFTA; bofs = WS_ZT; K = 128; oM = 1; oN = 1024; sync = 1; break;
        case 9:
          E.mode = pg8::E_FFTC; g.mode = pg8::GEO_A0; g.lda = 128; g.ldb = 128; aofs = WS_FFTC; bofs = WS_GP; K = 128; oM = 1; oN = 1024; sync = (l != 0); break;
        case 10:
          if (l != 0) { kind = SK_NONE; break; }
          E.mode = pg8::E_DFT2; E.aux = 1; g.mode = pg8::GEO_DFT2; g.aux = 1; g.lda = 512; g.ldb = 512; aofs = WS_DFTC; bofs = WS_ZTC; K = 512; oM = 1; oN = 16; rot = G - 64; sync = 1; break;
        case 11: case 13: case 15: {
          const int br = (sx - 11) >> 1; E.mode = pg8::E_GATE; E.aux = br; oM = 64; bofs = WS_WIN + (size_t)(18 * 256 + br * 2048) * 2048 * 2; break; }
        case 12: case 14: case 16: {
          const int br = (sx - 12) >> 1; E.mode = pg8::E_Y; E.aux = (br == 0); oM = 64;
          K = br == 2 ? 2048 : 1024; g.lda = K; g.ldb = K;
          aofs = br == 0 ? WS_F : (br == 1 ? WS_CBF : WS_O); bofs = br == 0 ? WS_WF : (br == 1 ? WS_WC : WS_WMLA);
          sync = (br == 2 && l != 0); break; }
        case 17: case 18: case 19: {
          if (l != 0) { kind = SK_NONE; break; }
          const int br = sx - 17; E.mode = pg8::E_GATE; E.aux = 4 + br; E.pm_off = 64; oM = 4; rot = 32 * (sx - 17);
          aofs = WS_H + (size_t)MX * 2048 * 2; bofs = WS_WIN + (size_t)(18 * 256 + br * 2048) * 2048 * 2; break; }
        case 20: case 21: case 22: {
          if (l != 0) { kind = SK_NONE; break; }
          const int br = sx - 20; E.mode = pg8::E_YC; E.aux = br; E.pm_off = 64; oM = 4; rot = 32 * (sx - 17);
          K = br == 2 ? 2048 : 1024; g.lda = K; g.ldb = K;
          aofs = (br == 0 ? WS_F : (br == 1 ? WS_CBF : WS_O)) + (size_t)MX * K * 2; bofs = br == 0 ? WS_WF : (br == 1 ? WS_WC : WS_WMLA);
          sync = (br == 2); break; }
        case 23: if (l != 0) { kind = SK_NONE; break; } kind = SK_CMERGE; sync = 1; break;
        case 24:
          E.mode = pg8::E_RES; E.aux = 0; oM = 64; aofs = WS_MERGED; bofs = WS_WOUT; sync = (l != 0); break;
        case 25:
          if (l != 0) { kind = SK_NONE; break; }
          E.mode = pg8::E_RES; E.aux = 8; E.pm_off = 64; g.mode = pg8::GEO_SPLITK; g.aux = 512; K = 512; oM = 4; oN = 32;
          aofs = WS_MERGED + (size_t)MX * 2048 * 2; bofs = WS_WOUT; sync = 1; break;
        case 26: kind = SK_NORM2; sync = 1; break;
        case 27:
          E.mode = pg8::E_UP; bofs = WS_WGU; oN = 44; sync = 1; break;
        case 28:
          E.mode = pg8::E_RES; E.aux = 1; oM = 64; g.lda = FFH; g.ldb = FFH; aofs = WS_HID; bofs = WS_WDN; K = FFH; sync = (l != 0); break;
        default:
          if (l != 0) { kind = SK_NONE; break; }
          E.mode = pg8::E_RES; E.aux = 9; E.pm_off = 64; g.mode = pg8::GEO_SPLITK; g.aux = 1408; g.lda = FFH; g.ldb = FFH; K = 1408; oM = 4; oN = 32;
          aofs = WS_HID + (size_t)MX * FFH * 2; bofs = WS_WDN; sync = 1; break;
      }
      if (kind == SK_GEMM) {
        pg8::Order S; S.init(oM, oN, G, (c.bx + G - rot % G) % G);
#ifndef NO_GEMM
        pg8::gemm_phase(lds3, (const bf16_t*)(ws + aofs), (const bf16_t*)(ws + bofs), K, S, g, E);
#endif
        base += oM * oN;
      } else if (kind == SK_P0) {
        const Params P = load_params();
        const float* mods_l = (const float*)(ws + WS_MODS) + (size_t)l * 5 * 12288;
        phase_wconv(P, c, l);
        phase_normmod(P, c, l == 0 ? P.x : P.out, l == 0 ? P.ctx : (const float*)(ws + WS_CTXX), P.norm_mix_g + l * 2048, mods_l, 0, MT, (bf16_t*)(ws + WS_H),
                      l == 0 ? nullptr : (const float*)(ws + WS_PART), (const float*)(ws + WS_MODS) + 4 * 12288 + 5 * 2048, nullptr);
        float* ssq_q = (float*)(ws + WS_SSQQ); float* ssq_kv = (float*)(ws + WS_SSQKV);
        for (int i = c.bx * 512 + opaque(c.tid); i < MT; i += G * 512) { ssq_q[i] = 0.f; ssq_kv[i] = 0.f; }
      } else if (kind == SK_CONV) {
        __syncthreads();
        const Params P = load_params();
#ifndef NO_CONV
        phase_conv(P, c, l, nM * 256, (c.bx + G - rot % G) % G);
#endif
      } else if (kind == SK_ATT) {
        const bf16_t* Qp = (const bf16_t*)(ws + WS_Q); const bf16_t* Kp = (const bf16_t*)(ws + WS_KN); const bf16_t* KPp = (const bf16_t*)(ws + WS_KPE); const bf16_t* Vp = (const bf16_t*)(ws + WS_V);
        bf16_t* Op = (bf16_t*)(ws + WS_O);
#ifndef NO_ATT
#pragma unroll 1
        for (int u = c.vcu; u < 1024 + (l == 0 ? 64 : 0); u += G) {
          int b, h, qrow, krow0, seq;
          if (u < 1024) { const int bh = u >> 4, qb = u & 15; b = bh >> 4; h = bh & 15; qrow = b * SEQ + qb * 256; krow0 = b * KVS; seq = KVS; }
          else { const int uc = u - 1024; b = uc >> 4; h = uc & 15; qrow = MX + b * CTXL; krow0 = b * KVS + SEQ; seq = CTXL; }
          att::attn_body(Qp + (size_t)qrow * 3072 + h * 192, Kp + (size_t)krow0 * 2048 + h * 128, KPp + (size_t)krow0 * 64, Vp + (size_t)krow0 * 2048 + h * 128,
                         Op + (size_t)qrow * 2048 + h * 128, seq, c.lds);
        }
#endif
        __syncthreads();
      } else if (kind == SK_CMERGE) {
        const u32x4* gc = (const u32x4*)(ws + WS_GATEC); const u32x4* yc = (const u32x4*)(ws + WS_YC); u32x4* mo = (u32x4*)((bf16_t*)(ws + WS_MERGED) + (size_t)MX * 2048);
        const int n8 = 1024 * 2048 / 8;
        for (int i = c.bx * 512 + opaque(c.tid); i < n8; i += G * 512) { f32x4 a0 = {0.f, 0.f, 0.f, 0.f}, a1 = a0;
#pragma unroll
          for (int b = 0; b < 3; ++b) { const u32x4 gw = gc[i + b * n8], yw = yc[i + b * n8];
            a0[0] += bflo(gw.x) * bflo(yw.x); a0[1] += bfhi(gw.x) * bfhi(yw.x); a0[2] += bflo(gw.y) * bflo(yw.y); a0[3] += bfhi(gw.y) * bfhi(yw.y);
            a1[0] += bflo(gw.z) * bflo(yw.z); a1[1] += bfhi(gw.z) * bfhi(yw.z); a1[2] += bflo(gw.w) * bflo(yw.w); a1[3] += bfhi(gw.w) * bfhi(yw.w); }
          mo[i] = pack8(a0, a1); }
      } else if (kind == SK_NORM2) {
        const Params P = load_params();
        const float* mods_l = (const float*)(ws + WS_MODS) + (size_t)l * 5 * 12288;
        phase_normmod(P, c, P.out, l == 0 ? P.ctx : (const float*)(ws + WS_CTXX), P.norm_ffn_g + l * 2048, mods_l, 3, nM * 256, (bf16_t*)(ws + WS_H),
                      l == 0 ? (const float*)(ws + WS_PART) : nullptr, mods_l + 4 * 12288 + 2 * 2048, l == 0 ? (float*)(ws + WS_CTXX) : nullptr);
      }
      if (sync) grid_barrier(ws, nbar_lds);
    }
  }
#ifdef CUT
  grid_barrier(ws, nbar_lds);
  { const Params P = load_params(); const long N = (long)MX * DM; const bf16_t* wb = (const bf16_t*)(ws + WS_H); const long NB16 = (long)(WS_END - WS_H) / 2;
    const float* misc = (const float*)ws;
    for (long i = (long)c.bx * 512 + c.tid; i < N; i += (long)G * 512) { float a = P.out[i];
      for (long e = i; e < NB16; e += N) a += __uint_as_float(((unsigned)wb[e]) << 16);
      if (i < (long)(3 * MiB)) a += misc[i];
      P.out[i] = a; } }
#else
  { const Params P = load_params(); phase_final(P, c); }
#endif
}

extern "C" void kernel_launch(void* const* d_in, const int* in_sizes, int n_in, void* d_out, int out_size, void* d_ws, size_t ws_size, hipStream_t stream) {
  static int grid_blocks = 0;
  if (!grid_blocks) {
    if (n_in != 26 || out_size != MX * DM || ws_size < WS_END) { fprintf(stderr, "kernel_launch: unexpected shapes / workspace (%d inputs, out %d, ws %zu < %zu)\n", n_in, out_size, ws_size, (size_t)WS_END); grid_blocks = -1; return; }
    int dev = 0, cus = 0, per_cu = 0;
    (void)hipGetDevice(&dev);
    (void)hipDeviceGetAttribute(&cus, hipDeviceAttributeMultiprocessorCount, dev);
    if (hipFuncSetAttribute((const void*)mk_fwd, hipFuncAttributeMaxDynamicSharedMemorySize, LDS_BYTES) != hipSuccess) { fprintf(stderr, "hipFuncSetAttribute failed\n"); grid_blocks = -1; return; }
    (void)hipOccupancyMaxActiveBlocksPerMultiprocessor(&per_cu, (const void*)mk_fwd, 512, LDS_BYTES);
    (void)hipGetLastError();
    grid_blocks = cus;
  }
  if (grid_blocks < 0) return;
  if (hipMemsetAsync(d_ws, 0, 1024, stream) != hipSuccess) { fprintf(stderr, "memset of barrier words failed\n"); return; }
  Params p{};
  const float** pp = (const float**)&p;
  for (int i = 0; i < 26; ++i) pp[i] = (const float*)d_in[i];
  p.out = (float*)d_out; p.ws = (unsigned char*)d_ws; p.ph_lo = 0; p.ph_hi = 1000;
  void* args[] = {&p};
  hipError_t e = hipLaunchCooperativeKernel((void*)mk_fwd, dim3(grid_blocks), dim3(512), args, LDS_BYTES, stream);
  if (e != hipSuccess) fprintf(stderr, "cooperative launch failed: %s (grid %d)\n", hipGetErrorString(e), grid_blocks);
}
```

```cpp
#include <hip/hip_runtime.h>
#include <hip/hip_cooperative_groups.h>
#include <cstdio>
#include <cstdint>
namespace cg = cooperative_groups;

#define LAS __attribute__((address_space(3)))
typedef unsigned short bf16_t;
typedef short bf16x8 __attribute__((ext_vector_type(8)));
typedef short s16x4 __attribute__((ext_vector_type(4)));
typedef float f32x4 __attribute__((ext_vector_type(4)));
typedef float f32x2 __attribute__((ext_vector_type(2)));
typedef float f32x16 __attribute__((ext_vector_type(16)));
typedef unsigned u32x4 __attribute__((ext_vector_type(4)));
typedef unsigned u32x2 __attribute__((ext_vector_type(2)));

constexpr int DM = 2048, NB = 4, SEQ = 4096, CTXL = 256;
constexpr int MX = NB * SEQ, MC = NB * CTXL, MT = MX + MC;
constexpr int KVS = SEQ + CTXL;
constexpr int F_END = 1024, C_END = 3072, Q_END = 3840, KV_END = 4352, KPE_END = 4416, IN_COLS = 10560;
constexpr int FFH = 5632;
constexpr float EPS = 1e-6f;

struct Params {
  const float *x, *c, *ctx, *c_ctx, *ada_w, *ada_b, *norm_mix_g, *w_in, *b_gate, *w_fourier, *conv_w, *conv_b, *conv_ln_g, *conv_ln_b,
      *w_conv_out, *q_norm_g, *w_uq, *kv_norm_g, *w_ukv, *w_mla_o, *w_out, *norm_ffn_g, *w_ffn_gate, *w_ffn_up, *w_ffn_down, *final_norm_g;
  float* out; unsigned char* ws; int ph_lo, ph_hi;
};

typedef const __attribute__((address_space(4))) Params* KArgP;
__device__ __forceinline__ KArgP kargs() { KArgP q = (KArgP)__builtin_amdgcn_kernarg_segment_ptr(); asm volatile("" : "+s"(q)); return q; }

constexpr size_t MiB = 1u << 20;
constexpr size_t WS_FLAGS = 0, WS_SSQQ = 64 * 1024, WS_SSQKV = 192 * 1024, WS_MODS = 512 * 1024, WS_ROPEC = 1 * MiB, WS_ROPES = 1 * MiB + 512 * 1024,
                 WS_CS1 = 2 * MiB, WS_DFTC = 2 * MiB + 256 * 1024,
                 WS_FFTA = 2 * MiB + 512 * 1024, WS_FFTC = WS_FFTA + 64 * 1024, WS_TWC = WS_FFTC + 64 * 1024, WS_TWS = WS_TWC + 16 * 1024;
constexpr size_t WS_CTXX = 4 * MiB, WS_GP = 12 * MiB;
constexpr size_t WS_WIN = 76 * MiB, WS_WF = 118 * MiB, WS_WC = 122 * MiB, WS_WUQ = 126 * MiB, WS_WUKV = 131 * MiB, WS_WMLA = 135 * MiB, WS_WOUT = 143 * MiB,
                 WS_WGU = 151 * MiB, WS_WDN = 195 * MiB;
constexpr size_t WS_H = 217 * MiB, WS_Q = 285 * MiB, WS_TMPG = 285 * MiB, WS_HID = 285 * MiB, WS_KN = 387 * MiB, WS_MERGED = 387 * MiB, WS_V = 455 * MiB,
                 WS_ZT = 523 * MiB, WS_ZTC = 587 * MiB, WS_CBF = 591 * MiB, WS_KPE = 625 * MiB, WS_UF = 628 * MiB, WS_O = 628 * MiB, WS_VB = 662 * MiB,
                 WS_QD = 696 * MiB, WS_F = 696 * MiB, WS_KVD = 722 * MiB, WS_GATEC = 739 * MiB, WS_YC = 751 * MiB, WS_PART = 763 * MiB, WS_END = 795 * MiB;

typedef __bf16 bf16x2_t __attribute__((ext_vector_type(2)));
__device__ __forceinline__ unsigned cvt_pk(float lo, float hi) { f32x2 v = {lo, hi}; bf16x2_t b = __builtin_convertvector(v, bf16x2_t); return __builtin_bit_cast(unsigned, b); }
__device__ __forceinline__ int opaque(int v) { asm volatile("" : "+v"(v)); return v; }
__device__ __forceinline__ float bflo(unsigned w) { return __uint_as_float(w << 16); }
__device__ __forceinline__ float bfhi(unsigned w) { return __uint_as_float(w & 0xffff0000u); }
__device__ __forceinline__ float fsigmoid(float x) { return __builtin_amdgcn_rcpf(1.f + __expf(-x)); }
__device__ __forceinline__ float wave_sum(float v) {
#pragma unroll
  for (int o = 1; o < 64; o <<= 1) v += __shfl_xor(v, o);
  return v;
}
__device__ __forceinline__ u32x4 pack8(f32x4 a, f32x4 b) { u32x4 w; w.x = cvt_pk(a[0], a[1]); w.y = cvt_pk(a[2], a[3]); w.z = cvt_pk(b[0], b[1]); w.w = cvt_pk(b[2], b[3]); return w; }
__device__ __forceinline__ int kvrow(int row) { return row < MX ? (row >> 12) * KVS + (row & 4095) : ((row - MX) >> 8) * KVS + SEQ + ((row - MX) & 255); }
__device__ __forceinline__ int modgrp(int row) { return row < MX ? (row >> 12) : 4; }

namespace pg8 {
constexpr int BM = 256, BK = 64, HALF = 128, HTB = HALF * BK * 2, STAGE_BYTES = 8 * HTB, NXCD = 8, WGM = 8;
__host__ __device__ __forceinline__ int lds_byte(int r, int c) { const int st = (r >> 4) * 2 + (c >> 5), rr = r & 15, cc = c & 31, ob = rr * 64 + cc * 2; return st * 1024 + (ob ^ (((ob >> 9) & 1) << 5)); }
__host__ __device__ __forceinline__ void stage_rc(int b, int& R, int& C) { const int st = b / 1024, sb = b % 1024, swz = sb ^ (((sb >> 9) & 1) << 5); R = (st >> 1) * 16 + swz / 64; C = (st & 1) * 32 + (swz % 64) / 2; }
__host__ __device__ __forceinline__ int perm32(int rho) { const int n = rho >> 4, i = rho & 15; return 8 * (i >> 2) + 4 * n + (i & 3); }
struct Unit { int pm, pn; };
struct Order {
  int nM, nN, nwg, G, c;
  __device__ void init(int nM_, int nN_, int G_, int c_) { nM = nM_; nN = nN_; nwg = nM * nN; G = G_; c = c_; }
  __device__ bool next(int i, Unit& u) const {
    const long L = (long)i * G + c; if (L >= nwg) return false;
    int wgid = (int)L; { const int q = nwg / NXCD, r = nwg % NXCD, xcd = wgid % NXCD, off = wgid / NXCD; wgid = (xcd < r ? xcd * (q + 1) : r * (q + 1) + (xcd - r) * q) + off; }
    const int nig = WGM * nN, gid = wgid / nig, fm = gid * WGM, gsz = (nM - fm) < WGM ? (nM - fm) : WGM;
    u.pm = fm + ((wgid % nig) % gsz); u.pn = (wgid % nig) / gsz; return true;
  }
};
enum { GEO_STD = 0, GEO_DFT1 = 1, GEO_DFT2 = 2, GEO_SPLITK = 3, GEO_A0 = 4 };
struct Geo {
  int mode; int lda, ldb; int aux;
  __device__ __forceinline__ size_t aoff(const Unit& u) const { if (mode == GEO_SPLITK) return (size_t)u.pm * BM * lda * 2 + (size_t)(u.pn >> 3) * aux * 2;
    return (mode == GEO_DFT1 || mode == GEO_A0) ? 0 : (size_t)u.pm * BM * lda * 2; }
  __device__ __forceinline__ size_t boff(const Unit& u) const {
    if (mode == GEO_STD) return (size_t)u.pn * BM * ldb * 2;
    if (mode == GEO_SPLITK) return (size_t)(u.pn & 7) * BM * ldb * 2 + (size_t)(u.pn >> 3) * aux * 2;
    if (mode == GEO_A0) return (size_t)u.pn * BM * ldb * 2;
    if (mode == GEO_DFT1) { const int tp = aux ? 1 : 16, seqlen = aux ? CTXL : SEQ; const int bg = u.pn / tp, pt = u.pn % tp, b = bg >> 3, g = bg & 7;
      return ((size_t)(b * seqlen + pt * (aux ? 256 : 4)) * 1024 + g * 128) * 2; }
    const int zl = aux ? 512 : 8192; const int b = u.pn >> 2, ct = u.pn & 3; return ((size_t)(b * 1024 + ct * 256) * zl) * 2;
  }
};

enum { E_IN = 0, E_DFT1, E_UQ, E_UKV, E_DFT2, E_GATE, E_Y, E_RES, E_UP, E_YC, E_FFTA, E_FFTC };
struct Epi {
  int mode; int pm_off, pn_off; int aux; int l; unsigned char* ws;
  __device__ __forceinline__ void operator()(const f32x4 (&acc)[2][2][4][2], const Unit& u, int wr, int wc, int fr_in, int fq_in) const {
    const int fr = opaque(fr_in), fq = opaque(fq_in);
    bf16_t *o0 = nullptr, *o1 = nullptr, *o2 = nullptr, *o3 = nullptr, *o4 = nullptr; const bf16_t* g0 = nullptr; float *s0 = nullptr, *s1 = nullptr; const float *c0 = nullptr, *c1 = nullptr;
    const float *xin_l = nullptr, *xin_c = nullptr; float *xout_l = nullptr, *xout_c = nullptr; int first = 0, seqlen = 0, tp = 1, zl = 0, rowbase = 0;
    switch (mode) {
      case E_IN: o0 = (bf16_t*)(ws + WS_UF); o1 = (bf16_t*)(ws + WS_VB); o2 = (bf16_t*)(ws + WS_QD); o3 = (bf16_t*)(ws + WS_KVD); o4 = (bf16_t*)(ws + WS_KPE);
        s0 = (float*)(ws + WS_SSQQ); s1 = (float*)(ws + WS_SSQKV); c0 = (const float*)(ws + WS_ROPEC); c1 = (const float*)(ws + WS_ROPES); break;
      case E_DFT1: o0 = (bf16_t*)(ws + (aux ? WS_ZTC : WS_ZT)); tp = aux ? 1 : 16; zl = aux ? 512 : 8192; break;
      case E_UQ: o0 = (bf16_t*)(ws + WS_Q); s0 = (float*)(ws + WS_SSQQ); c0 = (const float*)(ws + WS_ROPEC); c1 = (const float*)(ws + WS_ROPES); break;
      case E_UKV: o0 = (bf16_t*)(ws + WS_KN); o1 = (bf16_t*)(ws + WS_V); s1 = (float*)(ws + WS_SSQKV); break;
      case E_FFTA: o0 = (bf16_t*)(ws + WS_GP); c0 = (const float*)(ws + WS_TWC); c1 = (const float*)(ws + WS_TWS); break;
      case E_FFTC: o0 = (bf16_t*)(ws + WS_F); break;
      case E_DFT2: o0 = (bf16_t*)(ws + WS_F); seqlen = aux ? CTXL : SEQ; rowbase = aux ? MX : 0; break;
      case E_GATE: o0 = (aux & 4) ? (bf16_t*)(ws + WS_GATEC) + (size_t)(aux & 3) * 1024 * 2048 - (size_t)MX * 2048 : (bf16_t*)(ws + WS_TMPG); c0 = kargs()->b_gate + (size_t)l * 6144 + (aux & 3) * 2048; break;
      case E_YC: o0 = (bf16_t*)(ws + WS_YC) + (size_t)aux * 1024 * 2048 - (size_t)MX * 2048; break;
      case E_Y: o0 = (bf16_t*)(ws + WS_MERGED); g0 = (const bf16_t*)(ws + WS_TMPG); first = aux; break;
      case E_RES: { KArgP ka = kargs(); float* outp = ka->out; float* cx = (float*)(ws + WS_CTXX); const bool fresh = ((aux & 1) == 0 && l == 0);
        c0 = (const float*)(ws + WS_MODS) + (size_t)l * 5 * 12288 + ((aux & 1) ? 5 : 2) * 2048; xin_l = fresh ? ka->x : outp; xin_c = fresh ? ka->ctx : cx; xout_l = outp; xout_c = cx; break; }
      default: o0 = (bf16_t*)(ws + WS_HID); break;
    }
    const int pm = u.pm + pm_off, pn = u.pn + pn_off;
    const int cin = 32 * wc + 8 * fq;
    if (mode == E_IN) {
      if (pn < 4) {
#pragma unroll
        for (int ai = 0; ai < 2; ++ai)
#pragma unroll
          for (int m = 0; m < 4; ++m) { const int row = pm * 256 + ai * 128 + wr * 64 + m * 16 + fr;
#pragma unroll
            for (int bj = 0; bj < 2; ++bj) *(u32x4*)(o0 + (size_t)row * 1024 + pn * 256 + bj * 128 + cin) = pack8(acc[ai][bj][m][0], acc[ai][bj][m][1]); }
      } else if (pn < 12) {
        const int t = pn - 4;
#pragma unroll
        for (int ai = 0; ai < 2; ++ai)
#pragma unroll
          for (int m = 0; m < 4; ++m) { const int row = pm * 256 + ai * 128 + wr * 64 + m * 16 + fr;
            f32x4 v0, v1;
#pragma unroll
            for (int j = 0; j < 4; ++j) { v0[j] = acc[ai][0][m][0][j] * fsigmoid(acc[ai][1][m][0][j]); v1[j] = acc[ai][0][m][1][j] * fsigmoid(acc[ai][1][m][1][j]); }
            *(u32x4*)(o1 + (size_t)row * 1024 + t * 128 + cin) = pack8(v0, v1); }
      } else if (pn < 17) {
        const bool isq = pn < 15; bf16_t* ob = isq ? o2 : o3; const int ld = isq ? 768 : 512; const int ct = isq ? pn - 12 : pn - 15; float* ssq = isq ? s0 : s1;
#pragma unroll
        for (int ai = 0; ai < 2; ++ai)
#pragma unroll
          for (int m = 0; m < 4; ++m) { const int row = pm * 256 + ai * 128 + wr * 64 + m * 16 + fr; float s = 0.f;
#pragma unroll
            for (int bj = 0; bj < 2; ++bj) { const f32x4 a = acc[ai][bj][m][0], b = acc[ai][bj][m][1];
              s += (a[0] * a[0] + a[1] * a[1]) + (a[2] * a[2] + a[3] * a[3]) + (b[0] * b[0] + b[1] * b[1]) + (b[2] * b[2] + b[3] * b[3]);
              *(u32x4*)(ob + (size_t)row * ld + ct * 256 + bj * 128 + cin) = pack8(a, b); }
            s += __shfl_xor(s, 16); s += __shfl_xor(s, 32);
            if (fq == 0) atomicAdd(ssq + row, s); }
      } else {
        if (wc == 0) {
#pragma unroll
          for (int ai = 0; ai < 2; ++ai)
#pragma unroll
            for (int m = 0; m < 4; ++m) { const int row = pm * 256 + ai * 128 + wr * 64 + m * 16 + fr;
              f32x4 x1a = acc[ai][0][m][0], x1b = acc[ai][0][m][1], x2a = acc[ai][1][m][0], x2b = acc[ai][1][m][1], y1a = x1a, y1b = x1b, y2a = x2a, y2b = x2b;
              if (row < MX) { const int pos = row & 4095; const f32x4 ca = *(const f32x4*)(c0 + pos * 32 + cin), cb = *(const f32x4*)(c0 + pos * 32 + cin + 4), sa = *(const f32x4*)(c1 + pos * 32 + cin), sb = *(const f32x4*)(c1 + pos * 32 + cin + 4);
                y1a = x1a * ca - x2a * sa; y1b = x1b * cb - x2b * sb; y2a = x1a * sa + x2a * ca; y2b = x1b * sb + x2b * cb; }
              const int kr = kvrow(row);
              *(u32x4*)(o4 + (size_t)kr * 64 + cin) = pack8(y1a, y1b); *(u32x4*)(o4 + (size_t)kr * 64 + 32 + cin) = pack8(y2a, y2b); }
        }
      }
    } else if (mode == E_FFTA) {
      if (true) {
#pragma unroll
        for (int m2 = 0; m2 < 2; ++m2) { const int k1 = 32 * wr + 16 * m2 + fr;
#pragma unroll
          for (int bj = 0; bj < 2; ++bj) { const int nu = pn * 256 + bj * 128 + cin, n2 = nu & 63, chb = nu >> 6, ch = chb & 1023, b = chb >> 10;
            const f32x4 ca = *(const f32x4*)(c0 + k1 * 64 + n2), cb = *(const f32x4*)(c0 + k1 * 64 + n2 + 4), sa = *(const f32x4*)(c1 + k1 * 64 + n2), sb = *(const f32x4*)(c1 + k1 * 64 + n2 + 4);
            const f32x4 ra = acc[0][bj][m2][0], rb = acc[0][bj][m2][1], ia = acc[0][bj][m2 + 2][0], ib = acc[0][bj][m2 + 2][1];
            bf16_t* dst = o0 + ((size_t)((b * 64 + k1) * 1024 + ch)) * 128 + n2;
            *(u32x4*)dst = pack8(ra * ca + ia * sa, rb * cb + ib * sb); *(u32x4*)(dst + 64) = pack8(ia * ca - ra * sa, ib * cb - rb * sb); } }
      }
    } else if (mode == E_FFTC) {
      if (wr == 0) {
#pragma unroll
        for (int m = 0; m < 4; ++m) { const int k2 = 16 * m + fr;
#pragma unroll
          for (int bj = 0; bj < 2; ++bj) { const int nu = pn * 256 + bj * 128 + cin, ch = nu & 1023, k1 = (nu >> 10) & 63, b = nu >> 16;
            *(u32x4*)(o0 + ((size_t)(b * 4096 + k1 + 64 * k2)) * 1024 + ch) = pack8(acc[0][bj][m][0], acc[0][bj][m][1]); } }
      }
    } else if (mode == E_DFT1 && aux == 0) {
      const int bg = pn >> 4, pt = pn & 15, b = bg >> 3, g = bg & 7;
#pragma unroll
      for (int ai = 0; ai < 2; ++ai)
#pragma unroll
        for (int m = 0; m < 4; ++m) { const int l = wr * 64 + m * 16 + fr;
#pragma unroll
          for (int bj = 0; bj < 2; ++bj) { const int cl = bj * 128 + cin, n2 = 4 * pt + (cl >> 6), n1 = cl & 63;
            *(u32x4*)(o0 + ((size_t)((b * 1024 + g * 128 + l) * 64 + n2)) * 128 + ai * 64 + n1) = pack8(acc[ai][bj][m][0], acc[ai][bj][m][1]); } }
    } else if (mode == E_DFT1) {
      const int bg = pn / tp, pt = pn % tp, b = bg >> 3, g = bg & 7;
#pragma unroll
      for (int ai = 0; ai < 2; ++ai)
#pragma unroll
        for (int m = 0; m < 4; ++m) { const int l = wr * 64 + m * 16 + fr;
#pragma unroll
          for (int bj = 0; bj < 2; ++bj) *(u32x4*)(o0 + (size_t)(b * 1024 + g * 128 + l) * zl + ai * (zl >> 1) + pt * 256 + bj * 128 + cin) = pack8(acc[ai][bj][m][0], acc[ai][bj][m][1]); }
    } else if (mode == E_UQ) {
#pragma unroll
      for (int ai = 0; ai < 2; ++ai)
#pragma unroll
        for (int m = 0; m < 4; ++m) { const int row = pm * 256 + ai * 128 + wr * 64 + m * 16 + fr; const float rs = 1.0f / sqrtf(s0[row] * (1.f / 768.f) + EPS);
          if (pn < 8) {
#pragma unroll
            for (int bj = 0; bj < 2; ++bj) *(u32x4*)(o0 + (size_t)row * 3072 + (2 * pn + bj) * 192 + cin) = pack8(acc[ai][bj][m][0] * rs, acc[ai][bj][m][1] * rs);
          } else {
            const int head = 4 * (pn - 8) + wc, i0 = 8 * fq;
            f32x4 x1a = acc[ai][0][m][0] * rs, x1b = acc[ai][0][m][1] * rs, x2a = acc[ai][1][m][0] * rs, x2b = acc[ai][1][m][1] * rs, y1a = x1a, y1b = x1b, y2a = x2a, y2b = x2b;
            if (row < MX) { const int pos = row & 4095; const f32x4 ca = *(const f32x4*)(c0 + pos * 32 + i0), cb = *(const f32x4*)(c0 + pos * 32 + i0 + 4), sa = *(const f32x4*)(c1 + pos * 32 + i0), sb = *(const f32x4*)(c1 + pos * 32 + i0 + 4);
              y1a = x1a * ca - x2a * sa; y1b = x1b * cb - x2b * sb; y2a = x1a * sa + x2a * ca; y2b = x1b * sb + x2b * cb; }
            *(u32x4*)(o0 + (size_t)row * 3072 + head * 192 + 128 + i0) = pack8(y1a, y1b); *(u32x4*)(o0 + (size_t)row * 3072 + head * 192 + 160 + i0) = pack8(y2a, y2b);
          } }
    } else if (mode == E_UKV) {
      bf16_t* ob = pn < 8 ? o0 : o1; const int ct = pn < 8 ? pn : pn - 8;
#pragma unroll
      for (int ai = 0; ai < 2; ++ai)
#pragma unroll
        for (int m = 0; m < 4; ++m) { const int row = pm * 256 + ai * 128 + wr * 64 + m * 16 + fr; const float rs = 1.0f / sqrtf(s1[row] * (1.f / 512.f) + EPS); const int kr = kvrow(row);
#pragma unroll
          for (int bj = 0; bj < 2; ++bj) *(u32x4*)(ob + (size_t)kr * 2048 + ct * 256 + bj * 128 + cin) = pack8(acc[ai][bj][m][0] * rs, acc[ai][bj][m][1] * rs); }
    } else if (mode == E_DFT2) {
      const int b = pn >> 2, ct = pn & 3;
#pragma unroll
      for (int ai = 0; ai < 2; ++ai)
#pragma unroll
        for (int m = 0; m < 4; ++m) { const int row = rowbase + b * seqlen + pm * 256 + ai * 128 + wr * 64 + m * 16 + fr;
#pragma unroll
          for (int bj = 0; bj < 2; ++bj) *(u32x4*)(o0 + (size_t)row * 1024 + ct * 256 + bj * 128 + cin) = pack8(acc[ai][bj][m][0], acc[ai][bj][m][1]); }
    } else if (mode == E_GATE) {
#pragma unroll
      for (int bj = 0; bj < 2; ++bj) { const int col = pn * 256 + bj * 128 + cin; const f32x4 ba = *(const f32x4*)(c0 + col), bb = *(const f32x4*)(c0 + col + 4);
#pragma unroll
        for (int ai = 0; ai < 2; ++ai)
#pragma unroll
          for (int m = 0; m < 4; ++m) { const int row = pm * 256 + ai * 128 + wr * 64 + m * 16 + fr; f32x4 v0, v1;
#pragma unroll
            for (int j = 0; j < 4; ++j) { v0[j] = fsigmoid(acc[ai][bj][m][0][j] + ba[j]); v1[j] = fsigmoid(acc[ai][bj][m][1][j] + bb[j]); }
            *(u32x4*)(o0 + (size_t)row * 2048 + col) = pack8(v0, v1); } }
    } else if (mode == E_Y) {
#pragma unroll
      for (int am = 0; am < 4; ++am) { const int ai = am >> 1, mb = (am & 1) * 2; u32x4 gw[2][2], mw[2][2];
#pragma unroll
        for (int mm = 0; mm < 2; ++mm)
#pragma unroll
          for (int bj = 0; bj < 2; ++bj) { const int row = pm * 256 + ai * 128 + wr * 64 + (mb + mm) * 16 + fr; const size_t off = (size_t)row * 2048 + pn * 256 + bj * 128 + cin;
            gw[mm][bj] = *(const u32x4*)(g0 + off); mw[mm][bj] = first ? (u32x4){0u, 0u, 0u, 0u} : *(const u32x4*)(o0 + off); }
        asm volatile("" ::: "memory");
#pragma unroll
        for (int mm = 0; mm < 2; ++mm)
#pragma unroll
          for (int bj = 0; bj < 2; ++bj) { const int m = mb + mm; const int row = pm * 256 + ai * 128 + wr * 64 + m * 16 + fr; const size_t off = (size_t)row * 2048 + pn * 256 + bj * 128 + cin; const u32x4 g_ = gw[mm][bj], m_ = mw[mm][bj];
            f32x4 v0, v1; v0[0] = bflo(g_.x) * acc[ai][bj][m][0][0] + bflo(m_.x); v0[1] = bfhi(g_.x) * acc[ai][bj][m][0][1] + bfhi(m_.x); v0[2] = bflo(g_.y) * acc[ai][bj][m][0][2] + bflo(m_.y); v0[3] = bfhi(g_.y) * acc[ai][bj][m][0][3] + bfhi(m_.y);
            v1[0] = bflo(g_.z) * acc[ai][bj][m][1][0] + bflo(m_.z); v1[1] = bfhi(g_.z) * acc[ai][bj][m][1][1] + bfhi(m_.z); v1[2] = bflo(g_.w) * acc[ai][bj][m][1][2] + bflo(m_.w); v1[3] = bfhi(g_.w) * acc[ai][bj][m][1][3] + bfhi(m_.w);
            *(u32x4*)(o0 + off) = pack8(v0, v1); }
        asm volatile("" ::: "memory"); }
    } else if (mode == E_YC) {
#pragma unroll
      for (int ai = 0; ai < 2; ++ai)
#pragma unroll
        for (int m = 0; m < 4; ++m) { const int row = pm * 256 + ai * 128 + wr * 64 + m * 16 + fr;
#pragma unroll
          for (int bj = 0; bj < 2; ++bj) *(u32x4*)(o0 + (size_t)row * 2048 + pn * 256 + bj * 128 + cin) = pack8(acc[ai][bj][m][0], acc[ai][bj][m][1]); }
    } else if (mode == E_RES) {
      if (aux & 8) {
        float* pb = (float*)(ws + WS_PART) + (size_t)(pn >> 3) * 1024 * 2048; const int pnn = pn & 7;
#pragma unroll
        for (int ai = 0; ai < 2; ++ai)
#pragma unroll
          for (int m = 0; m < 4; ++m) { const int row = pm * 256 + ai * 128 + wr * 64 + m * 16 + fr - MX;
#pragma unroll
            for (int bj = 0; bj < 2; ++bj) { float* q = pb + (size_t)row * 2048 + pnn * 256 + bj * 128 + cin; *(f32x4*)q = acc[ai][bj][m][0]; *(f32x4*)(q + 4) = acc[ai][bj][m][1]; } }
        return;
      }
      {
        const int row0 = pm * 256; const bool lat = row0 < MX; const int mg = modgrp(row0);
        const float* xi0 = lat ? xin_l + (size_t)row0 * 2048 : xin_c + (size_t)(row0 - MX) * 2048; float* xo0 = lat ? xout_l + (size_t)row0 * 2048 : xout_c + (size_t)(row0 - MX) * 2048;
        f32x4 ga[2], gb[2];
#pragma unroll
        for (int bj = 0; bj < 2; ++bj) { const int col = pn * 256 + bj * 128 + cin; ga[bj] = *(const f32x4*)(c0 + mg * 12288 + col); gb[bj] = *(const f32x4*)(c0 + mg * 12288 + col + 4); }
#pragma unroll
        for (int am = 0; am < 4; ++am) { const int ai = am >> 1, mb = (am & 1) * 2; f32x4 xa[2][2], xb[2][2];
#pragma unroll
          for (int mm = 0; mm < 2; ++mm)
#pragma unroll
            for (int bj = 0; bj < 2; ++bj) { const size_t off = (size_t)(ai * 128 + wr * 64 + (mb + mm) * 16 + fr) * 2048 + pn * 256 + bj * 128 + cin; xa[mm][bj] = *(const f32x4*)(xi0 + off); xb[mm][bj] = *(const f32x4*)(xi0 + off + 4); }
          asm volatile("" ::: "memory");
#pragma unroll
          for (int mm = 0; mm < 2; ++mm)
#pragma unroll
            for (int bj = 0; bj < 2; ++bj) { const size_t off = (size_t)(ai * 128 + wr * 64 + (mb + mm) * 16 + fr) * 2048 + pn * 256 + bj * 128 + cin;
              *(f32x4*)(xo0 + off) = xa[mm][bj] + ga[bj] * acc[ai][bj][mb + mm][0]; *(f32x4*)(xo0 + off + 4) = xb[mm][bj] + gb[bj] * acc[ai][bj][mb + mm][1]; }
          asm volatile("" ::: "memory"); }
      }
    } else {
#pragma unroll
      for (int ai = 0; ai < 2; ++ai)
#pragma unroll
        for (int m = 0; m < 4; ++m) { const int row = pm * 256 + ai * 128 + wr * 64 + m * 16 + fr; f32x4 v0, v1;
#pragma unroll
          for (int j = 0; j < 4; ++j) { const float a = acc[ai][0][m][0][j], b = acc[ai][0][m][1][j]; v0[j] = a * fsigmoid(a) * acc[ai][1][m][0][j]; v1[j] = b * fsigmoid(b) * acc[ai][1][m][1][j]; }
          *(u32x4*)(o0 + (size_t)row * FFH + pn * 128 + cin) = pack8(v0, v1); }
    }
  }
};

__device__ __forceinline__ void gemm_phase(LAS unsigned char* lds, const bf16_t* Aop, const bf16_t* Bop, int K, const Order& S, const Geo& geo, const Epi& E) {
  const int tid = opaque(threadIdx.x), wid = __builtin_amdgcn_readfirstlane(tid >> 6), lane = tid & 63, wr = wid >> 2, wc = wid & 3, fr = lane & 15, fq = lane >> 4;
  const int nt = K / BK;
  unsigned voffA[2], voffB[2];
  const bool rperm = (geo.mode == GEO_DFT1 && geo.aux == 0);
#pragma unroll
  for (int i = 0; i < 2; ++i) { int R, C; stage_rc(tid * 16 + i * 8192, R, C); const int Rb = (R & ~31) + perm32(R & 31); const int Rg = rperm ? 64 * (Rb & 63) + (Rb >> 6) : Rb;
    voffA[i] = (unsigned)(R * geo.lda + C) * 2u; voffB[i] = (unsigned)(Rg * geo.ldb + C) * 2u; }
  const size_t kstep = (size_t)(BK * 2);
  const size_t hstepA = (size_t)HALF * geo.lda * 2, hstepB = rperm ? (size_t)2 * geo.ldb * 2 : (size_t)HALF * geo.ldb * 2;
  const unsigned ldsw = (unsigned)wid * 1024u;
  const int aoff = lds_byte(wr * 64 + fr, fq * 8), boff = lds_byte(wc * 32 + fr, fq * 8);
#define PG8_SA(b, h) (((b) * 2 + (h)) * HTB)
#define PG8_SB(b, h) ((4 + (b) * 2 + (h)) * HTB)
#define PG8_STAGE(bufoff, gbase, voff) do { _Pragma("unroll") for (int _i = 0; _i < 2; ++_i) \
        __builtin_amdgcn_global_load_lds((const unsigned*)((const char*)(gbase) + (voff)[_i]), (LAS unsigned*)(lds + (bufoff) + ldsw + _i * 8192), 16, 0, 0); } while (0)
#define PG8_LDA(dst, b, h) do { _Pragma("unroll") for (int m = 0; m < 4; ++m) _Pragma("unroll") for (int k = 0; k < 2; ++k) dst[m][k] = *(const LAS bf16x8*)(lds + PG8_SA(b, h) + aoff + m * 2048 + k * 1024); } while (0)
#define PG8_LDB(dst, b, h) do { _Pragma("unroll") for (int n = 0; n < 2; ++n) _Pragma("unroll") for (int k = 0; k < 2; ++k) dst[n][k] = *(const LAS bf16x8*)(lds + PG8_SB(b, h) + boff + n * 2048 + k * 1024); } while (0)
#define PG8_MMA(ai, bj, At, Bt) do { __builtin_amdgcn_s_setprio(1); _Pragma("unroll") for (int m = 0; m < 4; ++m) _Pragma("unroll") for (int n = 0; n < 2; ++n) _Pragma("unroll") for (int k = 0; k < 2; ++k) \
        acc[ai][bj][m][n] = __builtin_amdgcn_mfma_f32_16x16x32_bf16(Bt[n][k], At[m][k], acc[ai][bj][m][n], 0, 0, 0); __builtin_amdgcn_s_setprio(0); } while (0)
#define PG8_WAIT_V(n) asm volatile("s_waitcnt vmcnt(" #n ")" ::: "memory")
#define PG8_WAIT_L(n) asm volatile("s_waitcnt lgkmcnt(" #n ")" ::: "memory")
#define PG8_BAR __builtin_amdgcn_s_barrier()
#define PG8_SCHED __builtin_amdgcn_sched_barrier(0)
  Unit cur, nxt; int ui = 0;
  if (!S.next(0, cur)) return;
  f32x4 acc[2][2][4][2];
#pragma unroll
  for (int a = 0; a < 2; ++a)
#pragma unroll
    for (int b = 0; b < 2; ++b)
#pragma unroll
      for (int m = 0; m < 4; ++m)
#pragma unroll
        for (int n = 0; n < 2; ++n) acc[a][b][m][n] = (f32x4){0.f, 0.f, 0.f, 0.f};
  bf16x8 At[4][2], B0[2][2], B1[2][2];
  const char* cA = (const char*)Aop + geo.aoff(cur); const char* cB = (const char*)Bop + geo.boff(cur);
  PG8_STAGE(PG8_SB(0, 0), cB, voffB); PG8_STAGE(PG8_SB(0, 1), cB + hstepB, voffB); PG8_STAGE(PG8_SA(0, 0), cA, voffA); PG8_STAGE(PG8_SA(0, 1), cA + hstepA, voffA);
  if (wr == 1) PG8_BAR;
  PG8_WAIT_V(2); PG8_BAR;
  PG8_STAGE(PG8_SB(1, 0), cB + kstep, voffB); PG8_STAGE(PG8_SA(1, 0), cA + kstep, voffA); PG8_STAGE(PG8_SB(1, 1), cB + hstepB + kstep, voffB);
  PG8_WAIT_V(6); PG8_BAR;
  for (;;) {
    const bool has_next = S.next(ui + 1, nxt);
    const char* nA = has_next ? (const char*)Aop + geo.aoff(nxt) : cA; const char* nB = has_next ? (const char*)Bop + geo.boff(nxt) : cB;
    for (int t = 0; t < nt; t += 2) {
      const bool last = (t == nt - 2);
      const char* a1 = cA + (size_t)(t + 1) * kstep;
      const char* a2 = last ? nA : cA + (size_t)(t + 2) * kstep; const char* b2 = last ? nB : cB + (size_t)(t + 2) * kstep;
      const char* a3 = a2 + kstep; const char* b3 = b2 + kstep;
      PG8_LDB(B0, 0, 0); PG8_LDB(B1, 0, 1); PG8_SCHED; PG8_LDA(At, 0, 0); PG8_STAGE(PG8_SA(1, 1), a1 + hstepA, voffA);
      PG8_WAIT_V(8); PG8_WAIT_L(0); PG8_BAR; PG8_MMA(0, 0, At, B0); PG8_MMA(0, 1, At, B1); PG8_BAR; PG8_SCHED;
      PG8_LDA(At, 0, 1); PG8_STAGE(PG8_SB(0, 0), b2, voffB); PG8_STAGE(PG8_SB(0, 1), b2 + hstepB, voffB); PG8_STAGE(PG8_SA(0, 0), a2, voffA);
      PG8_WAIT_V(8); PG8_WAIT_L(0); PG8_BAR; PG8_MMA(1, 0, At, B0); PG8_MMA(1, 1, At, B1); PG8_BAR; PG8_SCHED;
      PG8_LDB(B0, 1, 0); PG8_LDB(B1, 1, 1); PG8_SCHED; PG8_LDA(At, 1, 0); PG8_STAGE(PG8_SA(0, 1), a2 + hstepA, voffA);
      PG8_WAIT_V(8); PG8_WAIT_L(0); PG8_BAR; PG8_MMA(0, 0, At, B0); PG8_MMA(0, 1, At, B1); PG8_BAR; PG8_SCHED;
      PG8_LDA(At, 1, 1); PG8_STAGE(PG8_SB(1, 0), b3, voffB); PG8_STAGE(PG8_SB(1, 1), b3 + hstepB, voffB); PG8_STAGE(PG8_SA(1, 0), a3, voffA);
      PG8_WAIT_V(8); PG8_WAIT_L(0); PG8_BAR; PG8_MMA(1, 0, At, B0); PG8_MMA(1, 1, At, B1); PG8_BAR; PG8_SCHED;
    }
    if (wr == 0) PG8_BAR;
    E(acc, cur, wr, wc, fr, fq);
    if (!has_next) break;
#pragma unroll
    for (int a = 0; a < 2; ++a)
#pragma unroll
      for (int b = 0; b < 2; ++b)
#pragma unroll
        for (int m = 0; m < 4; ++m)
#pragma unroll
          for (int n = 0; n < 2; ++n) acc[a][b][m][n] = (f32x4){0.f, 0.f, 0.f, 0.f};
    cur = nxt; cA = nA; cB = nB; ++ui;
    if (wr == 1) PG8_BAR;
  }
  PG8_WAIT_V(0);
  PG8_BAR;
#undef PG8_SA
#undef PG8_SB
#undef PG8_STAGE
#undef PG8_LDA
#undef PG8_LDB
#undef PG8_MMA
#undef PG8_WAIT_V
#undef PG8_WAIT_L
#undef PG8_BAR
#undef PG8_SCHED
}
}

namespace att {
constexpr int NW = 8, QBLK = 32, KVBLK = 64;
constexpr float SCALE = 0.07216878364870322f;
constexpr float THR = 8.f;
constexpr int SDEPTH = 1;
constexpr int LDQ = 3072, LDK = 2048, LDKP = 64, LDO = 2048;
constexpr int SHM_V = 16384, SHM_K = 16384, SHM_KP = 8192;
constexpr int OFF_V = 0, OFF_K = 2 * SHM_V, OFF_KP = OFF_K + 2 * SHM_K, OFF_WS = OFF_KP + 2 * SHM_KP, OFF_QP = OFF_WS + NW * 64 * 4, QP_WAVE = 32 * 208, SHM_ATTN = OFF_QP + NW * QP_WAVE;
#define KSWZ(row, colB) ((row) * 256 + ((colB) ^ (((row) & 7) << 4)))
#define KPSWZ(row, colB) ((row) * 128 + ((colB) ^ (((row) & 7) << 4)))
#define SBAR() __builtin_amdgcn_sched_barrier(0)
__device__ __forceinline__ int crow(int r, int hi) { return (r & 3) + 8 * (r >> 2) + 4 * hi; }
__device__ __forceinline__ void partialSM(f32x16& p0, f32x16& p1, float& m_reg, float& mn, float& alpha) {
  constexpr float C = SCALE * 1.4426950408889634f;
#define MX3(a, b, c) __builtin_fmaxf(__builtin_fmaxf((a), (b)), (c))
  float ma = MX3(p0[0], p0[1], p1[0]), mb = MX3(p0[2], p0[3], p1[1]); ma = MX3(ma, p1[2], p1[3]);
#pragma unroll
  for (int r = 4; r < 16; r += 4) { ma = MX3(ma, p0[r], p0[r + 1]); mb = MX3(mb, p0[r + 2], p0[r + 3]); ma = MX3(ma, p1[r], p1[r + 1]); mb = MX3(mb, p1[r + 2], p1[r + 3]); }
  float pmax = __builtin_fmaxf(ma, mb);
#undef MX3
  { auto rr = __builtin_amdgcn_permlane32_swap(__float_as_uint(pmax), __float_as_uint(pmax), false, false);
    pmax = fmaxf(__uint_as_float(rr[0]), __uint_as_float(rr[1])); }
  if (__builtin_expect(__all(pmax - m_reg <= THR / SCALE), 1)) { mn = m_reg; alpha = 1.f; }
  else { mn = fmaxf(m_reg, pmax); alpha = __builtin_amdgcn_exp2f((m_reg - mn) * C); m_reg = mn; }
  float mnC = -mn * C;
#pragma unroll
  for (int r = 0; r < 16; ++r) p0[r] = fmaf(p0[r], C, mnC);
#pragma unroll
  for (int r = 0; r < 16; ++r) p1[r] = fmaf(p1[r], C, mnC);
#pragma unroll
  for (int r = 0; r < 16; ++r) p0[r] = __builtin_amdgcn_exp2f(p0[r]);
}
__device__ __forceinline__ void finishSM(f32x16& p0, f32x16& p1, float alpha, float& l_reg, bf16x8& pa0, bf16x8& pa1, bf16x8& pa2, bf16x8& pa3) {
#pragma unroll
  for (int r = 0; r < 16; ++r) p1[r] = __builtin_amdgcn_exp2f(p1[r]);
  float ps0 = 0.f, ps1 = 0.f, ps2 = 0.f, ps3 = 0.f;
#pragma unroll
  for (int r = 0; r < 16; r += 4) { ps0 += p0[r] + p1[r]; ps1 += p0[r + 1] + p1[r + 1]; ps2 += p0[r + 2] + p1[r + 2]; ps3 += p0[r + 3] + p1[r + 3]; }
  float ps = (ps0 + ps1) + (ps2 + ps3);
  { auto rr = __builtin_amdgcn_permlane32_swap(__float_as_uint(ps), __float_as_uint(ps), false, false);
    ps = __uint_as_float(rr[0]) + __uint_as_float(rr[1]); }
  l_reg = l_reg * alpha + ps;
#define PK4(P, BASE, OUT) do { unsigned a0 = cvt_pk(P[BASE + 0], P[BASE + 1]), a1 = cvt_pk(P[BASE + 2], P[BASE + 3]);   \
    unsigned b0 = cvt_pk(P[BASE + 4], P[BASE + 5]), b1 = cvt_pk(P[BASE + 6], P[BASE + 7]);                              \
    auto r0 = __builtin_amdgcn_permlane32_swap(a0, b0, false, false); auto r1 = __builtin_amdgcn_permlane32_swap(a1, b1, false, false); \
    u32x4 w = {r0[0], r1[0], r0[1], r1[1]}; OUT = *reinterpret_cast<bf16x8*>(&w); } while (0)
  PK4(p0, 0, pa0); PK4(p0, 8, pa1); PK4(p1, 0, pa2); PK4(p1, 8, pa3);
#undef PK4
}
__device__ __forceinline__ void qkt(f32x16& p0, f32x16& p1, const char* Ks, const char* KPs, const char* QPs, const bf16x8* qr, int r32, int hi) {
  p0 = f32x16{}; p1 = f32x16{};
  const char* qrow = QPs + r32 * 208 + hi * 16;
#pragma unroll
  for (int d0 = 0; d0 < 8; ++d0) { int cb = (d0 * 16 + hi * 8) * 2;
    bf16x8 b0 = *reinterpret_cast<const bf16x8*>(Ks + KSWZ(r32, cb));
    bf16x8 b1 = *reinterpret_cast<const bf16x8*>(Ks + KSWZ(32 + r32, cb));
    bf16x8 qf; if (d0 < 6) qf = qr[d0]; else qf = *reinterpret_cast<const bf16x8*>(qrow + (d0 - 6) * 32);
    p0 = __builtin_amdgcn_mfma_f32_32x32x16_bf16(b0, qf, p0, 0, 0, 0);
    p1 = __builtin_amdgcn_mfma_f32_32x32x16_bf16(b1, qf, p1, 0, 0, 0); }
#pragma unroll
  for (int d0 = 0; d0 < 4; ++d0) { int cb = (d0 * 16 + hi * 8) * 2;
    bf16x8 b0 = *reinterpret_cast<const bf16x8*>(KPs + KPSWZ(r32, cb));
    bf16x8 b1 = *reinterpret_cast<const bf16x8*>(KPs + KPSWZ(32 + r32, cb));
    bf16x8 qf = *reinterpret_cast<const bf16x8*>(qrow + (d0 + 2) * 32);
    p0 = __builtin_amdgcn_mfma_f32_32x32x16_bf16(b0, qf, p0, 0, 0, 0);
    p1 = __builtin_amdgcn_mfma_f32_32x32x16_bf16(b1, qf, p1, 0, 0, 0); }
}
__device__ __forceinline__ int v_st(int k, int c) { const int kk = (k & ~0xC) | ((k & 4) << 1) | ((k & 8) >> 1); return ((kk >> 3) * 4 + (c >> 5)) * 512 + ((kk & 7) * 32 + (c & 31)) * 2; }
__device__ __forceinline__ int v_rd_base(int lane) { return ((lane & 3) << 3) | (((lane >> 2) & 3) << 6) | (((lane >> 4) & 1) << 5) | (((lane >> 5) & 1) << 8); }
constexpr int v_rd_off(int d0, int ks, int half) { return d0 * 512 + ks * 4096 + half * 2048; }
template <int OFF> __device__ __forceinline__ s16x4 tr_read(int vb) {
  s16x4 r; asm volatile("ds_read_b64_tr_b16 %0, %1 offset:%2" : "=&v"(r) : "v"(vb), "i"(OFF) : "memory"); return r;
}
template <int D0> __device__ __forceinline__ void pv_one(f32x16& od, int vb, bf16x8 pa0, bf16x8 pa1, bf16x8 pa2, bf16x8 pa3) {
  const s16x4 l0 = tr_read<v_rd_off(D0, 0, 0)>(vb), h0 = tr_read<v_rd_off(D0, 0, 1)>(vb), l1 = tr_read<v_rd_off(D0, 1, 0)>(vb), h1 = tr_read<v_rd_off(D0, 1, 1)>(vb);
  const s16x4 l2 = tr_read<v_rd_off(D0, 2, 0)>(vb), h2 = tr_read<v_rd_off(D0, 2, 1)>(vb), l3 = tr_read<v_rd_off(D0, 3, 0)>(vb), h3 = tr_read<v_rd_off(D0, 3, 1)>(vb);
  asm volatile("s_waitcnt lgkmcnt(0)" ::: "memory"); SBAR();
#define PK(L, H) (bf16x8){L[0], L[1], L[2], L[3], H[0], H[1], H[2], H[3]}
  od = __builtin_amdgcn_mfma_f32_32x32x16_bf16(pa0, PK(l0, h0), od, 0, 0, 0);
  od = __builtin_amdgcn_mfma_f32_32x32x16_bf16(pa1, PK(l1, h1), od, 0, 0, 0);
  od = __builtin_amdgcn_mfma_f32_32x32x16_bf16(pa2, PK(l2, h2), od, 0, 0, 0);
  od = __builtin_amdgcn_mfma_f32_32x32x16_bf16(pa3, PK(l3, h3), od, 0, 0, 0);
#undef PK
}
__device__ __forceinline__ void pv_d0(f32x16* o, int vb, bf16x8 pa0, bf16x8 pa1, bf16x8 pa2, bf16x8 pa3) {
  pv_one<0>(o[0], vb, pa0, pa1, pa2, pa3); pv_one<1>(o[1], vb, pa0, pa1, pa2, pa3); pv_one<2>(o[2], vb, pa0, pa1, pa2, pa3); pv_one<3>(o[3], vb, pa0, pa1, pa2, pa3);
}
__device__ __forceinline__ void attn_body(const bf16_t* __restrict__ Qb, const bf16_t* __restrict__ Kh, const bf16_t* __restrict__ KPh, const bf16_t* __restrict__ Vh,
                                          bf16_t* __restrict__ Ob, int seq, char* lds) {
  const int tid = opaque(threadIdx.x), wid = tid >> 6, lane = tid & 63, r32 = lane & 31, hi = lane >> 5;
  char* V_lds = lds + OFF_V; char* K_lds = lds + OFF_K; char* KP_lds = lds + OFF_KP;
  float* ws = (float*)(lds + OFF_WS) + wid * 64; float* li_l = ws; float* al_l = ws + 32;
  float m_reg = -1e30f, l_reg = 0; f32x16 o[4] = {}; bf16x8 qr[6];
  char* QP_lds = lds + OFF_QP + wid * QP_WAVE;
  const bf16_t* Qw = Qb + (long)(wid * QBLK + r32) * LDQ + hi * 8;
#pragma unroll
  for (int d0 = 0; d0 < 6; ++d0) qr[d0] = *reinterpret_cast<const bf16x8*>(Qw + d0 * 16);
#pragma unroll
  for (int d0 = 6; d0 < 12; ++d0) *reinterpret_cast<bf16x8*>(QP_lds + r32 * 208 + hi * 16 + (d0 - 6) * 32) = *reinterpret_cast<const bf16x8*>(Qw + d0 * 16);
  const int sr = tid >> 4, sc = (tid & 15) * 8, vst0 = v_st(sr, sc), vst1 = v_st(32 + sr, sc);
  const int pr = tid >> 3, pc = (tid & 7) * 8;
  const int vb0 = (int)(uintptr_t)V_lds + v_rd_base(lane);
  struct { bf16x8 vs0, vs1, ks0, ks1, kp; } sr_[SDEPTH];
#define SLOAD(i, k0) do { sr_[i].vs0 = *reinterpret_cast<const bf16x8*>(&Vh[(long)((k0) + sr) * LDK + sc]); sr_[i].vs1 = *reinterpret_cast<const bf16x8*>(&Vh[(long)((k0) + 32 + sr) * LDK + sc]); \
    sr_[i].ks0 = *reinterpret_cast<const bf16x8*>(&Kh[(long)((k0) + sr) * LDK + sc]); sr_[i].ks1 = *reinterpret_cast<const bf16x8*>(&Kh[(long)((k0) + 32 + sr) * LDK + sc]); \
    sr_[i].kp = *reinterpret_cast<const bf16x8*>(&KPh[(long)((k0) + pr) * LDKP + pc]); } while (0)
#define SWRITE(b, i) do { *(bf16x8*)(V_lds + (b) * SHM_V + vst0) = sr_[i].vs0;          \
    *(bf16x8*)(V_lds + (b) * SHM_V + vst1) = sr_[i].vs1; int kc = sc * 2;               \
    *(bf16x8*)(K_lds + (b) * SHM_K + KSWZ(sr, kc)) = sr_[i].ks0;                       \
    *(bf16x8*)(K_lds + (b) * SHM_K + KSWZ(32 + sr, kc)) = sr_[i].ks1;                  \
    *(bf16x8*)(KP_lds + (b) * SHM_KP + KPSWZ(pr, pc * 2)) = sr_[i].kp; } while (0)
#define SWAIT() do { if constexpr (SDEPTH == 2) asm volatile("s_waitcnt vmcnt(5)" ::: "memory"); else asm volatile("s_waitcnt vmcnt(0)" ::: "memory"); } while (0)
#define RESC(a) do { if (__any((a) < 1.f)) { if (hi == 0) al_l[r32] = (a); asm volatile("s_waitcnt lgkmcnt(0)" ::: "memory"); \
    _Pragma("unroll") for (int d = 0; d < 4; ++d) _Pragma("unroll") for (int r = 0; r < 16; ++r) o[d][r] *= al_l[crow(r, hi)]; } } while (0)
  f32x16 pA0, pA1, pB0, pB1; float mnA, mnB, alA, alB; bf16x8 pa0, pa1, pa2, pa3; const int NT = seq / KVBLK;
  constexpr int SE = 0, SO = SDEPTH - 1;
  SLOAD(SE, 0); asm volatile("s_waitcnt vmcnt(0)" ::: "memory"); SWRITE(0, SE); __syncthreads();
  qkt(pA0, pA1, K_lds, KP_lds, QP_lds, qr, r32, hi); partialSM(pA0, pA1, m_reg, mnA, alA);
  SLOAD(SO, KVBLK); if constexpr (SDEPTH == 2) { if (2 < NT) SLOAD(SE, 2 * KVBLK); }
  SWAIT(); SWRITE(1, SO); __syncthreads();
  for (int j = 1; j + 1 < NT; j += 2) {
    SBAR(); qkt(pB0, pB1, K_lds + SHM_K, KP_lds + SHM_KP, QP_lds, qr, r32, hi);
    finishSM(pA0, pA1, alA, l_reg, pa0, pa1, pa2, pa3); SBAR();
    SLOAD(SO, (j + SDEPTH) * KVBLK); SBAR();
    pv_d0(o, vb0, pa0, pa1, pa2, pa3); partialSM(pB0, pB1, m_reg, mnB, alB);
    __syncthreads(); SWAIT(); SWRITE(0, SE);
    RESC(alB); __syncthreads();
    SBAR(); qkt(pA0, pA1, K_lds, KP_lds, QP_lds, qr, r32, hi);
    finishSM(pB0, pB1, alB, l_reg, pa0, pa1, pa2, pa3); SBAR();
    if (SDEPTH == 1 || j + 3 < NT) SLOAD(SE, (j + 1 + SDEPTH) * KVBLK); SBAR();
    pv_d0(o, vb0 + SHM_V, pa0, pa1, pa2, pa3); partialSM(pA0, pA1, m_reg, mnA, alA);
    __syncthreads(); SWAIT(); SWRITE(1, SO);
    RESC(alA); __syncthreads();
  }
  SBAR(); qkt(pB0, pB1, K_lds + SHM_K, KP_lds + SHM_KP, QP_lds, qr, r32, hi);
  finishSM(pA0, pA1, alA, l_reg, pa0, pa1, pa2, pa3); SBAR();
  pv_d0(o, vb0, pa0, pa1, pa2, pa3); partialSM(pB0, pB1, m_reg, mnB, alB);
  __syncthreads(); RESC(alB);
  finishSM(pB0, pB1, alB, l_reg, pa0, pa1, pa2, pa3); SBAR();
  pv_d0(o, vb0 + SHM_V, pa0, pa1, pa2, pa3);
  if (hi == 0) li_l[r32] = l_reg; asm volatile("s_waitcnt lgkmcnt(0)" ::: "memory");
  float rli[16];
#pragma unroll
  for (int r = 0; r < 16; ++r) rli[r] = __builtin_amdgcn_rcpf(li_l[crow(r, hi)]);
  bf16_t* Ow = Ob + (long)(wid * QBLK) * LDO;
#pragma unroll
  for (int r = 0; r < 16; ++r) { int orow = crow(r, hi);
#pragma unroll
    for (int d0 = 0; d0 < 4; ++d0) Ow[(long)orow * LDO + d0 * 32 + r32] = (bf16_t)(cvt_pk(o[d0][r] * rli[r], 0.f) & 0xffffu); }
  __syncthreads();
#undef SLOAD
#undef SWRITE
#undef SWAIT
#undef RESC
}
#undef SBAR
}

struct Ctx { int tid, lane, wave, G, bx, vcu; char* lds; };

__device__ __forceinline__ void phase_mods(const Params& p, const Ctx& c_in) {
  Ctx c = c_in; c.tid = opaque(c_in.tid); c.lane = c.tid & 63; c.wave = __builtin_amdgcn_readfirstlane(c.tid >> 6);
  float* sl = (float*)c.lds;
  float* red = sl + 5 * 2048;
  for (int i = c.tid; i < 5 * 2048; i += 512) { const int r = i >> 11, k = i & 2047; const float v = r < 4 ? p.c[r * 2048 + k] : p.c_ctx[k]; sl[i] = v * fsigmoid(v); }
  __syncthreads();
  float* mods = (float*)(p.ws + WS_MODS);
  for (int ch = c.bx; ch < 256; ch += c.G) {
    const int l = ch >> 7, n0 = (ch & 127) * 96;
    const int cgp = c.tid % 24, ks = c.tid / 24;
    float a[5][4];
#pragma unroll
    for (int r = 0; r < 5; ++r)
#pragma unroll
      for (int j = 0; j < 4; ++j) a[r][j] = 0.f;
    if (c.tid < 384) {
      const float* W = p.ada_w + (size_t)l * 2048 * 12288 + n0 + 4 * cgp;
      for (int k = ks; k < 2048; k += 16) { const f32x4 w = *(const f32x4*)(W + (size_t)k * 12288);
#pragma unroll
        for (int r = 0; r < 5; ++r) { const float s = sl[r * 2048 + k];
#pragma unroll
          for (int j = 0; j < 4; ++j) a[r][j] += s * w[j]; } }
#pragma unroll
      for (int r = 0; r < 5; ++r)
#pragma unroll
        for (int j = 0; j < 4; ++j) red[(ks * 24 + cgp) * 20 + r * 4 + j] = a[r][j];
    }
    __syncthreads();
    if (c.tid < 480) { const int r = c.tid / 96, n = c.tid % 96, cg2 = n >> 2, j = n & 3; float s = 0.f;
      for (int q = 0; q < 16; ++q) s += red[(q * 24 + cg2) * 20 + r * 4 + j];
      mods[((size_t)l * 5 + r) * 12288 + n0 + n] = s + p.ada_b[l * 12288 + n0 + n]; }
    __syncthreads();
  }
}
__device__ __forceinline__ void phase_tables(const Params& p, const Ctx& c_in) {
  Ctx c = c_in; c.tid = opaque(c_in.tid); c.lane = c.tid & 63; c.wave = __builtin_amdgcn_readfirstlane(c.tid >> 6);
  float* T = (float*)c.lds;
  for (int i = c.tid; i < 4096; i += 512) T[i] = cosf((float)i * (6.283185307179586f / 4096.f)) * (1.f / 64.f);
  __syncthreads();
  const long gt = (long)c.bx * 512 + c.tid, GT = (long)c.G * 512;
  float* rc = (float*)(p.ws + WS_ROPEC); float* rs = (float*)(p.ws + WS_ROPES);
  for (long i = gt; i < 4096 * 32; i += GT) { const int pos = (int)(i >> 5), f = (int)(i & 31);
    const float inv = powf(10000.f, -(float)(f & 15) / 16.f); const float ang = (float)(f < 16 ? (pos >> 6) : (pos & 63)) * inv;
    rc[i] = cosf(ang); rs[i] = sinf(ang); }
  { bf16_t* fa = (bf16_t*)(p.ws + WS_FFTA); bf16_t* fc = (bf16_t*)(p.ws + WS_FFTC); float* twc = (float*)(p.ws + WS_TWC); float* tws = (float*)(p.ws + WS_TWS);
    for (long i = gt; i < 256 * 128; i += GT) { const int rho = (int)(i >> 7), kap = (int)(i & 127), cc = kap >> 6, nn = kap & 63;
      float va = 0.f, vc = 0.f;
      if (rho < 128) { const int wr_ = rho >> 6, m_ = (rho >> 4) & 3, fr_ = rho & 15, k1 = 32 * wr_ + 16 * (m_ & 1) + fr_, isim = m_ >> 1, r = (k1 * nn) & 63;
        const float cs_ = T[(64 * r) & 4095] * 8.f, sn_ = T[(64 * r + 3072) & 4095] * 8.f;
        va = isim ? (cc ? -cs_ : -sn_) : (cc ? -sn_ : cs_); }
      if (rho < 64) { const int r = (rho * nn) & 63; vc = cc ? T[(64 * r + 3072) & 4095] * 8.f : T[(64 * r) & 4095] * 8.f; }
      fa[i] = (bf16_t)(cvt_pk(va, 0.f) & 0xffffu); fc[i] = (bf16_t)(cvt_pk(vc, 0.f) & 0xffffu); }
    for (long i = gt; i < 64 * 64; i += GT) { const int k1 = (int)(i >> 6), n2 = (int)(i & 63), r = k1 * n2; twc[i] = T[r & 4095] * 64.f; tws[i] = T[(r + 3072) & 4095] * 64.f; } }
  bf16_t* dc = (bf16_t*)(p.ws + WS_DFTC);
  for (long i = gt; i < 256 * 512; i += GT) { const int m = (int)(i >> 9), kk = (int)(i & 511), n = kk & 255, s = kk >> 8;
    dc[i] = (bf16_t)(cvt_pk(T[(((m * n + 64 * s) & 255) * 16) & 4095] * 4.f, 0.f) & 0xffffu); }
  bf16_t* cs = (bf16_t*)(p.ws + WS_CS1);
  for (long i = gt; i < 256 * 128; i += GT) { const int jp = (int)(i >> 7), j = (int)(i & 127), l = jp & 127, s = jp >> 7;
    cs[i] = (bf16_t)(cvt_pk(T[(((l * j) & 127) * 32 + 3072 * s) & 4095] * 5.656854249492381f, 0.f) & 0xffffu); }
  __syncthreads();
}

enum { J_IN = 0, J_F, J_C, J_UQ, J_UKV, J_MLA, J_OUT, J_GU, J_DN, J_NUM };
struct WJob { const float* src; const float* src2; const float* gain; bf16_t* dst; int K, Nd, ldn, kind; };
__device__ __forceinline__ const float* wsrc(const WJob& j, int n0) {
  const int tile = n0 >> 8, r = n0 & 255;
  switch (j.kind) {
    case J_IN:
      if (tile < 4) return j.src + n0;
      if (tile < 12) { const int t = tile - 4; return j.src + (r < 128 ? F_END + 128 * t + r : F_END + 1024 + 128 * t + (r - 128)); }
      if (tile < 15) return j.src + C_END + (n0 - 12 * 256);
      if (tile < 17) return j.src + Q_END + (n0 - 15 * 256);
      if (tile == 17) return r == 0 ? j.src + KV_END : (r == 128 ? j.src + KV_END + 32 : nullptr);
      return j.src + KPE_END + (n0 - 18 * 256);
    case J_UQ:
      if (tile < 8) return j.src + (n0 >> 7) * 192 + (n0 & 127);
      { const int t = tile - 8, bj = r >> 7, wc = (r >> 5) & 3; return j.src + (4 * t + wc) * 192 + 128 + bj * 32; }
    case J_UKV:
      if (tile < 8) return j.src + (n0 >> 7) * 256 + (n0 & 127);
      { const int n1 = n0 - 2048; return j.src + (n1 >> 7) * 256 + 128 + (n1 & 127); }
    case J_GU:
      return (r < 128 ? j.src : j.src2) + 128 * tile + (r & 127);
    default: return j.src + n0;
  }
}
__device__ __forceinline__ void transpose_item(const WJob& j, int item, LAS float* scr, int lane) {
  const int nblk = j.Nd / 64, kb = item / nblk, nb = item % nblk, k0 = 64 * kb, n0 = 64 * nb;
  const int col4 = (lane & 15) * 4;
  const float* s = wsrc(j, n0 + (col4 & 32));
  f32x4 v[16];
#pragma unroll
  for (int i = 0; i < 16; ++i) { const int kk = 4 * i + (lane >> 4); v[i] = (f32x4){0.f, 0.f, 0.f, 0.f};
    if (s) { v[i] = *(const f32x4*)(s + (size_t)(k0 + kk) * j.ldn + (col4 & 31)); if (j.gain) v[i] = v[i] * j.gain[k0 + kk]; } }
#pragma unroll
  for (int i = 0; i < 16; ++i) { const int kk = 4 * i + (lane >> 4);
#pragma unroll
    for (int e = 0; e < 4; ++e) scr[kk * 65 + col4 + e] = v[i][e]; }
  asm volatile("s_waitcnt lgkmcnt(0)" ::: "memory");
  const int cch = lane & 7;
#pragma unroll
  for (int q = 0; q < 8; ++q) { const int n = (lane >> 3) + 8 * q; const LAS float* t = scr + (8 * cch) * 65 + n;
    u32x4 o; o.x = cvt_pk(t[0 * 65], t[1 * 65]); o.y = cvt_pk(t[2 * 65], t[3 * 65]); o.z = cvt_pk(t[4 * 65], t[5 * 65]); o.w = cvt_pk(t[6 * 65], t[7 * 65]);
    *(u32x4*)(j.dst + (size_t)(n0 + n) * j.K + k0 + 8 * cch) = o; }
  asm volatile("s_waitcnt lgkmcnt(0)" ::: "memory");
}
__device__ __forceinline__ void phase_wconv(const Params& p, const Ctx& c_in, int l) {
  Ctx c = c_in; c.tid = opaque(c_in.tid); c.lane = c.tid & 63; c.wave = __builtin_amdgcn_readfirstlane(c.tid >> 6);
  LAS float* scr = (LAS float*)((LAS unsigned char*)c.lds + c.wave * 16640);
  const int gw = c.vcu * 8 + c.wave, NGW = c.G * 8;
  unsigned char* ws = p.ws;
#pragma unroll 1
  for (int jk = 0; jk < J_NUM; ++jk) {
    WJob j; j.src2 = nullptr; j.gain = nullptr; j.kind = jk;
    switch (jk) {
      case J_IN: j.src = p.w_in + (size_t)l * 2048 * IN_COLS; j.dst = (bf16_t*)(ws + WS_WIN); j.K = 2048; j.Nd = 10752; j.ldn = IN_COLS; break;
      case J_F: j.src = p.w_fourier + (size_t)l * 1024 * 2048; j.dst = (bf16_t*)(ws + WS_WF); j.K = 1024; j.Nd = 2048; j.ldn = 2048; break;
      case J_C: j.src = p.w_conv_out + (size_t)l * 1024 * 2048; j.dst = (bf16_t*)(ws + WS_WC); j.K = 1024; j.Nd = 2048; j.ldn = 2048; break;
      case J_UQ: j.src = p.w_uq + (size_t)l * 768 * 3072; j.gain = p.q_norm_g + l * 768; j.dst = (bf16_t*)(ws + WS_WUQ); j.K = 768; j.Nd = 3072; j.ldn = 3072; break;
      case J_UKV: j.src = p.w_ukv + (size_t)l * 512 * 4096; j.gain = p.kv_norm_g + l * 512; j.dst = (bf16_t*)(ws + WS_WUKV); j.K = 512; j.Nd = 4096; j.ldn = 4096; break;
      case J_MLA: j.src = p.w_mla_o + (size_t)l * 2048 * 2048; j.dst = (bf16_t*)(ws + WS_WMLA); j.K = 2048; j.Nd = 2048; j.ldn = 2048; break;
      case J_OUT: j.src = p.w_out + (size_t)l * 2048 * 2048; j.dst = (bf16_t*)(ws + WS_WOUT); j.K = 2048; j.Nd = 2048; j.ldn = 2048; break;
      case J_GU: j.src = p.w_ffn_gate + (size_t)l * 2048 * FFH; j.src2 = p.w_ffn_up + (size_t)l * 2048 * FFH; j.dst = (bf16_t*)(ws + WS_WGU); j.K = 2048; j.Nd = 2 * FFH; j.ldn = FFH; break;
      default: j.src = p.w_ffn_down + (size_t)l * FFH * 2048; j.dst = (bf16_t*)(ws + WS_WDN); j.K = FFH; j.Nd = 2048; j.ldn = 2048; break;
    }
    const int nitems = (j.K / 64) * (j.Nd / 64);
    for (int it = gw; it < nitems; it += NGW) transpose_item(j, it, scr, c.lane);
  }
}
__device__ __forceinline__ void phase_normmod(const Params& p, const Ctx& c_in, const float* xl, const float* xc, const float* gain, const float* mods_l, int sh_idx, int nrows, bf16_t* hout,
                                              const float* part, const float* pgate, float* xstore) {
  Ctx c = c_in; c.tid = opaque(c_in.tid); c.lane = c.tid & 63; c.wave = __builtin_amdgcn_readfirstlane(c.tid >> 6);
  const int gw = c.vcu * 8 + c.wave, NGW = c.G * 8;
  for (int row = gw; row < nrows; row += NGW) {
    const float* xr = row < MX ? xl + (size_t)row * 2048 : xc + (size_t)(row - MX) * 2048;
    const float* md = mods_l + modgrp(row) * 12288;
    f32x4 v[8]; float ss = 0.f;
#pragma unroll
    for (int q = 0; q < 8; ++q) { const int col = q * 256 + c.lane * 4; v[q] = *(const f32x4*)(xr + col);
      if (part && row >= MX) { const float* pr = part + (size_t)(row - MX) * 2048 + col; const size_t ps = (size_t)1024 * 2048;
        const f32x4 sum = (*(const f32x4*)pr + *(const f32x4*)(pr + ps)) + (*(const f32x4*)(pr + 2 * ps) + *(const f32x4*)(pr + 3 * ps));
        v[q] = v[q] + *(const f32x4*)(pgate + col) * sum; if (xstore) *(f32x4*)(xstore + (size_t)(row - MX) * 2048 + col) = v[q]; }
      ss += (v[q][0] * v[q][0] + v[q][1] * v[q][1]) + (v[q][2] * v[q][2] + v[q][3] * v[q][3]); }
    const float rstd = 1.0f / sqrtf(wave_sum(ss) * (1.f / 2048.f) + EPS);
#pragma unroll
    for (int q = 0; q < 8; ++q) { const int col = q * 256 + c.lane * 4; const f32x4 g = *(const f32x4*)(gain + col), sh = *(const f32x4*)(md + sh_idx * 2048 + col), sc = *(const f32x4*)(md + (sh_idx + 1) * 2048 + col);
      const f32x4 y = v[q] * rstd * g * (sc + 1.f) + sh; u32x2 w; w.x = cvt_pk(y[0], y[1]); w.y = cvt_pk(y[2], y[3]);
      *(u32x2*)(hout + (size_t)row * 2048 + col) = w; }
  }
}
__device__ __forceinline__ void phase_conv(const Params& p, const Ctx& c_in, int l, int nrows, int cidx) {
  Ctx c = c_in; c.tid = opaque(c_in.tid); c.lane = c.tid & 63; c.wave = __builtin_amdgcn_readfirstlane(c.tid >> 6);
  constexpr int TT = 16, HALO = 15, NR = TT + 2 * HALO;
  const bf16_t* vb = (const bf16_t*)(p.ws + WS_VB); bf16_t* ob = (bf16_t*)(p.ws + WS_CBF);
  unsigned* tile = (unsigned*)c.lds;
  f32x2* red = (f32x2*)(c.lds + NR * 2048);
  const int ch = 2 * c.tid;
  float w0[31], w1[31];
#pragma unroll
  for (int k = 0; k < 31; ++k) { const f32x2 w = *(const f32x2*)(p.conv_w + ((size_t)l * 31 + k) * 1024 + ch); w0[k] = w[0]; w1[k] = w[1]; }
  const f32x2 cb = *(const f32x2*)(p.conv_b + l * 1024 + ch), lg = *(const f32x2*)(p.conv_ln_g + l * 1024 + ch), lb = *(const f32x2*)(p.conv_ln_b + l * 1024 + ch);
  const int ntiles = nrows / TT;
  for (int t = cidx; t < ntiles; t += c.G) {
    const int r0 = t * TT; const int seqlen = r0 < MX ? SEQ : CTXL; const int sbeg = r0 < MX ? (r0 & ~(SEQ - 1)) : MX + ((r0 - MX) & ~(CTXL - 1)); const int send = sbeg + seqlen;
    for (int i = c.tid; i < NR * 128; i += 512) { const int rr = i >> 7, cc = i & 127, row = r0 - HALO + rr; u32x4 v = {0u, 0u, 0u, 0u};
      if (row >= sbeg && row < send) v = *(const u32x4*)(vb + (size_t)row * 1024 + cc * 8);
      *(u32x4*)(tile + rr * 512 + cc * 4) = v; }
    __syncthreads();
    float y0[TT], y1[TT];
#pragma unroll
    for (int tt = 0; tt < TT; ++tt) { float a0 = cb[0], a1 = cb[1];
#pragma unroll
      for (int k = 0; k < 31; ++k) { const unsigned w = tile[(tt + k) * 512 + c.tid]; a0 += bflo(w) * w0[k]; a1 += bfhi(w) * w1[k]; }
      y0[tt] = a0; y1[tt] = a1;
      const float s = wave_sum(a0 + a1), q = wave_sum(a0 * a0 + a1 * a1);
      if (c.lane == 0) red[tt * 8 + c.wave] = (f32x2){s, q}; }
    __syncthreads();
#pragma unroll
    for (int tt = 0; tt < TT; ++tt) { float s = 0.f, q = 0.f;
#pragma unroll
      for (int w = 0; w < 8; ++w) { const f32x2 r = red[tt * 8 + w]; s += r[0]; q += r[1]; }
      const float mu = s * (1.f / 1024.f); const float var = fmaxf(q * (1.f / 1024.f) - mu * mu, 0.f); const float rstd = 1.0f / sqrtf(var + EPS);
      float z0 = (y0[tt] - mu) * rstd * lg[0] + lb[0], z1 = (y1[tt] - mu) * rstd * lg[1] + lb[1];
      z0 = z0 * fsigmoid(z0); z1 = z1 * fsigmoid(z1);
      *(unsigned*)(ob + (size_t)(r0 + tt) * 1024 + ch) = cvt_pk(z0, z1); }
    __syncthreads();
  }
}
__device__ __forceinline__ void phase_final(const Params& p, const Ctx& c_in) {
  Ctx c = c_in; c.tid = opaque(c_in.tid); c.lane = c.tid & 63; c.wave = __builtin_amdgcn_readfirstlane(c.tid >> 6);
  const int gw = c.vcu * 8 + c.wave, NGW = c.G * 8;
  for (int row = gw; row < MX; row += NGW) { float* xr = p.out + (size_t)row * 2048; f32x4 v[8]; float ss = 0.f;
#pragma unroll
    for (int q = 0; q < 8; ++q) { v[q] = *(const f32x4*)(xr + q * 256 + c.lane * 4); ss += (v[q][0] * v[q][0] + v[q][1] * v[q][1]) + (v[q][2] * v[q][2] + v[q][3] * v[q][3]); }
    const float rstd = 1.0f / sqrtf(wave_sum(ss) * (1.f / 2048.f) + EPS);
#pragma unroll
    for (int q = 0; q < 8; ++q) { const int col = q * 256 + c.lane * 4; *(f32x4*)(xr + col) = v[q] * rstd * *(const f32x4*)(p.final_norm_g + col); } }
}

constexpr int LDS_BYTES = 147456;
__device__ __forceinline__ void grid_barrier(unsigned char* ws, volatile LAS unsigned* nbar_lds) {
  asm volatile("s_waitcnt vmcnt(0) lgkmcnt(0)" ::: "memory");
  __syncthreads();
  if (threadIdx.x == 0) {
    unsigned* bar = (unsigned*)(ws + WS_FLAGS); const unsigned G = gridDim.x, nbar = *nbar_lds;
    __builtin_amdgcn_fence(__ATOMIC_RELEASE, "agent"); asm volatile("s_waitcnt vmcnt(0)" ::: "memory");
    const unsigned old = __hip_atomic_fetch_add(bar, 1u, __ATOMIC_RELAXED, __HIP_MEMORY_SCOPE_AGENT);
    if (old + 1u == G * (nbar + 1u)) __hip_atomic_store(bar + 64, nbar + 1u, __ATOMIC_RELAXED, __HIP_MEMORY_SCOPE_AGENT);
    else while (__hip_atomic_load(bar + 64, __ATOMIC_RELAXED, __HIP_MEMORY_SCOPE_AGENT) <= nbar) __builtin_amdgcn_s_sleep(2);
    __builtin_amdgcn_fence(__ATOMIC_ACQUIRE, "agent"); asm volatile("s_waitcnt vmcnt(0)" ::: "memory");
    *nbar_lds = nbar + 1u;
  }
  __syncthreads();
}
enum { SK_NONE = 0, SK_GEMM, SK_P0, SK_CONV, SK_ATT, SK_NORM2, SK_CMERGE };
constexpr int NSTEP = 31;
__device__ __forceinline__ Params load_params() { KArgP ka = kargs(); Params P; __builtin_memcpy(&P, (const void*)ka, sizeof(Params)); return P; }
__global__ void __launch_bounds__(512, 2) mk_fwd(Params p_unused) {
  extern __shared__ __attribute__((aligned(16))) unsigned char lds_raw[];
  cg::grid_group grid = cg::this_grid();
  Ctx c; c.tid = threadIdx.x; c.lane = c.tid & 63; c.wave = __builtin_amdgcn_readfirstlane(c.tid >> 6); c.G = gridDim.x; c.bx = blockIdx.x;
  c.vcu = (c.G % 8 == 0) ? (c.bx % 8) * (c.G / 8) + c.bx / 8 : c.bx; c.lds = (char*)lds_raw;
  LAS unsigned char* lds3 = (LAS unsigned char*)lds_raw;
  unsigned char* ws = kargs()->ws;
  const int G = c.G;

  volatile LAS unsigned* nbar_lds = (volatile LAS unsigned*)(lds3 + LDS_BYTES - 64);
  if (c.tid == 0) *nbar_lds = 0u;
  grid.sync();
  { const Params P = load_params(); phase_mods(P, c); phase_tables(P, c); }
  grid_barrier(ws, nbar_lds);

#pragma unroll 1
  for (int l = 0; l < 2; ++l) {
    const int nM = l == 0 ? 68 : 64;
    int base = 0;
#pragma unroll 1
    for (int st = 0; st < NSTEP; ++st) {
      int kind = SK_GEMM, sync = 0, K = 2048, oM = nM, oN = 8, rot = 0;
      size_t aofs = WS_H, bofs = WS_WIN;
      pg8::Epi E{}; E.l = l; E.ws = ws; pg8::Geo g{}; g.mode = pg8::GEO_STD; g.lda = 2048; g.ldb = 2048;
      const int sx = st < 8 ? st : (st == 8 ? 100 : st - 1);
      switch (sx) {
        case 0: kind = SK_P0; sync = 1; break;
        case 1:
          E.mode = pg8::E_IN; oN = 18; sync = (l == 0); break;
        case 2:
          if (l == 0) { kind = SK_NONE; break; }
          E.mode = pg8::E_IN; E.pm_off = 64; E.pn_off = 15; aofs = WS_H + (size_t)MX * 2048 * 2; bofs = WS_WIN + (size_t)15 * 256 * 2048 * 2; oM = 4; oN = 3; rot = 64 * 18; sync = 1; break;
        case 3:
          E.mode = pg8::E_DFT1; g.mode = pg8::GEO_DFT1; g.lda = 128; g.ldb = 1024; aofs = WS_CS1; bofs = WS_UF; K = 128; oM = 1; oN = 512; base = 0; break;
        case 4:
          if (l != 0) { kind = SK_NONE; break; }
          E.mode = pg8::E_DFT1; E.aux = 1; g.mode = pg8::GEO_DFT1; g.aux = 1; g.lda = 128; g.ldb = 1024; aofs = WS_CS1; bofs = WS_UF + (size_t)MX * 1024 * 2; K = 128; oM = 1; oN = 32; rot = base; break;
        case 5:
          E.mode = pg8::E_UQ; g.lda = 768; g.ldb = 768; aofs = WS_QD; bofs = WS_WUQ; K = 768; oN = 12; rot = base; break;
        case 6:
          E.mode = pg8::E_UKV; g.lda = 512; g.ldb = 512; aofs = WS_KVD; bofs = WS_WUKV; K = 512; oM = 68; oN = 16; rot = base; break;
        case 7: kind = SK_CONV; rot = base; sync = 1; break;
        case 8: kind = SK_ATT; break;
        case 100:
          E.mode = pg8::E_FFTA; g.mode = pg8::GEO_A0; g.lda = 128; g.ldb = 128; aofs = WS_FFTA; bofs = WS_ZT; K = 128; oM = 1; oN = 1024; sync = 1; break;
        case 9:
          E.mode = pg8::E_FFTC; g.mode = pg8::GEO_A0; g.lda = 128; g.ldb = 128; aofs = WS_FFTC; bofs = WS_GP; K = 128; oM = 1; oN = 1024; sync = (l != 0); break;
        case 10:
          if (l != 0) { kind = SK_NONE; break; }
          E.mode = pg8::E_DFT2; E.aux = 1; g.mode = pg8::GEO_DFT2; g.aux = 1; g.lda = 512; g.ldb = 512; aofs = WS_DFTC; bofs = WS_ZTC; K = 512; oM = 1; oN = 16; rot = G - 64; sync = 1; break;
        case 11: case 13: case 15: {
          const int br = (sx - 11) >> 1; E.mode = pg8::E_GATE; E.aux = br; oM = 64; bofs = WS_WIN + (size_t)(18 * 256 + br * 2048) * 2048 * 2; break; }
        case 12: case 14: case 16: {
          const int br = (sx - 12) >> 1; E.mode = pg8::E_Y; E.aux = (br == 0); oM = 64;
          K = br == 2 ? 2048 : 1024; g.lda = K; g.ldb = K;
          aofs = br == 0 ? WS_F : (br == 1 ? WS_CBF : WS_O); bofs = br == 0 ? WS_WF : (br == 1 ? WS_WC : WS_WMLA);
          sync = (br == 2 && l != 0); break; }
        case 17: case 18: case 19: {
          if (l != 0) { kind = SK_NONE; break; }
          const int br = sx - 17; E.mode = pg8::E_GATE; E.aux = 4 + br; E.pm_off = 64; oM = 4; rot = 32 * (sx - 17);
          aofs = WS_H + (size_t)MX * 2048 * 2; bofs = WS_WIN + (size_t)(18 * 256 + br * 2048) * 2048 * 2; break; }
        case 20: case 21: case 22: {
          if (l != 0) { kind = SK_NONE; break; }
          const int br = sx - 20; E.mode = pg8::E_YC; E.aux = br; E.pm_off = 64; oM = 4; rot = 32 * (sx - 17);
          K = br == 2 ? 2048 : 1024; g.lda = K; g.ldb = K;
          aofs = (br == 0 ? WS_F : (br == 1 ? WS_CBF : WS_O)) + (size_t)MX * K * 2; bofs = br == 0 ? WS_WF : (br == 1 ? WS_WC : WS_WMLA);
          sync = (br == 2); break; }
        case 23: if (l != 0) { kind = SK_NONE; break; } kind = SK_CMERGE; sync = 1; break;
        case 24:
          E.mode = pg8::E_RES; E.aux = 0; oM = 64; aofs = WS_MERGED; bofs = WS_WOUT; sync = (l != 0); break;
        case 25:
          if (l != 0) { kind = SK_NONE; break; }
          E.mode = pg8::E_RES; E.aux = 8; E.pm_off = 64; g.mode = pg8::GEO_SPLITK; g.aux = 512; K = 512; oM = 4; oN = 32;
          aofs = WS_MERGED + (size_t)MX * 2048 * 2; bofs = WS_WOUT; sync = 1; break;
        case 26: kind = SK_NORM2; sync = 1; break;
        case 27:
          E.mode = pg8::E_UP; bofs = WS_WGU; oN = 44; sync = 1; break;
        case 28:
          E.mode = pg8::E_RES; E.aux = 1; oM = 64; g.lda = FFH; g.ldb = FFH; aofs = WS_HID; bofs = WS_WDN; K = FFH; sync = (l != 0); break;
        default:
          if (l != 0) { kind = SK_NONE; break; }
          E.mode = pg8::E_RES; E.aux = 9; E.pm_off = 64; g.mode = pg8::GEO_SPLITK; g.aux = 1408; g.lda = FFH; g.ldb = FFH; K = 1408; oM = 4; oN = 32;
          aofs = WS_HID + (size_t)MX * FFH * 2; bofs = WS_WDN; sync = 1; break;
      }
      if (kind == SK_GEMM) {
        pg8::Order S; S.init(oM, oN, G, (c.bx + G - rot % G) % G);
#ifndef NO_GEMM
        pg8::gemm_phase(lds3, (const bf16_t*)(ws + aofs), (const bf16_t*)(ws + bofs), K, S, g, E);
#endif
        base += oM * oN;
      } else if (kind == SK_P0) {
        const Params P = load_params();
        const float* mods_l = (const float*)(ws + WS_MODS) + (size_t)l * 5 * 12288;
        phase_wconv(P, c, l);
        phase_normmod(P, c, l == 0 ? P.x : P.out, l == 0 ? P.ctx : (const float*)(ws + WS_CTXX), P.norm_mix_g + l * 2048, mods_l, 0, MT, (bf16_t*)(ws + WS_H),
                      l == 0 ? nullptr : (const float*)(ws + WS_PART), (const float*)(ws + WS_MODS) + 4 * 12288 + 5 * 2048, nullptr);
        float* ssq_q = (float*)(ws + WS_SSQQ); float* ssq_kv = (float*)(ws + WS_SSQKV);
        for (int i = c.bx * 512 + opaque(c.tid); i < MT; i += G * 512) { ssq_q[i] = 0.f; ssq_kv[i] = 0.f; }
      } else if (kind == SK_CONV) {
        __syncthreads();
        const Params P = load_params();
#ifndef NO_CONV
        phase_conv(P, c, l, nM * 256, (c.bx + G - rot % G) % G);
#endif
      } else if (kind == SK_ATT) {
        const bf16_t* Qp = (const bf16_t*)(ws + WS_Q); const bf16_t* Kp = (const bf16_t*)(ws + WS_KN); const bf16_t* KPp = (const bf16_t*)(ws + WS_KPE); const bf16_t* Vp = (const bf16_t*)(ws + WS_V);
        bf16_t* Op = (bf16_t*)(ws + WS_O);
#ifndef NO_ATT
#pragma unroll 1
        for (int u = c.vcu; u < 1024 + (l == 0 ? 64 : 0); u += G) {
          int b, h, qrow, krow0, seq;
          if (u < 1024) { const int bh = u >> 4, qb = u & 15; b = bh >> 4; h = bh & 15; qrow = b * SEQ + qb * 256; krow0 = b * KVS; seq = KVS; }
          else { const int uc = u - 1024; b = uc >> 4; h = uc & 15; qrow = MX + b * CTXL; krow0 = b * KVS + SEQ; seq = CTXL; }
          att::attn_body(Qp + (size_t)qrow * 3072 + h * 192, Kp + (size_t)krow0 * 2048 + h * 128, KPp + (size_t)krow0 * 64, Vp + (size_t)krow0 * 2048 + h * 128,
                         Op + (size_t)qrow * 2048 + h * 128, seq, c.lds);
        }
#endif
        __syncthreads();
      } else if (kind == SK_CMERGE) {
        const u32x4* gc = (const u32x4*)(ws + WS_GATEC); const u32x4* yc = (const u32x4*)(ws + WS_YC); u32x4* mo = (u32x4*)((bf16_t*)(ws + WS_MERGED) + (size_t)MX * 2048);
        const int n8 = 1024 * 2048 / 8;
        for (int i = c.bx * 512 + opaque(c.tid); i < n8; i += G * 512) { f32x4 a0 = {0.f, 0.f, 0.f, 0.f}, a1 = a0;
#pragma unroll
          for (int b = 0; b < 3; ++b) { const u32x4 gw = gc[i + b * n8], yw = yc[i + b * n8];
            a0[0] += bflo(gw.x) * bflo(yw.x); a0[1] += bfhi(gw.x) * bfhi(yw.x); a0[2] += bflo(gw.y) * bflo(yw.y); a0[3] += bfhi(gw.y) * bfhi(yw.y);
            a1[0] += bflo(gw.z) * bflo(yw.z); a1[1] += bfhi(gw.z) * bfhi(yw.z); a1[2] += bflo(gw.w) * bflo(yw.w); a1[3] += bfhi(gw.w) * bfhi(yw.w); }
          mo[i] = pack8(a0, a1); }
      } else if (kind == SK_NORM2) {
        const Params P = load_params();
        const float* mods_l = (const float*)(ws + WS_MODS) + (size_t)l * 5 * 12288;
        phase_normmod(P, c, P.out, l == 0 ? P.ctx : (const float*)(ws + WS_CTXX), P.norm_ffn_g + l * 2048, mods_l, 3, nM * 256, (bf16_t*)(ws + WS_H),
                      l == 0 ? (const float*)(ws + WS_PART) : nullptr, mods_l + 4 * 12288 + 2 * 2048, l == 0 ? (float*)(ws + WS_CTXX) : nullptr);
      }
      if (sync) grid_barrier(ws, nbar_lds);
    }
  }
#ifdef CUT
  grid_barrier(ws, nbar_lds);
  { const Params P = load_params(); const long N = (long)MX * DM; const bf16_t* wb = (const bf16_t*)(ws + WS_H); const long NB16 = (long)(WS_END - WS_H) / 2;
    const float* misc = (const float*)ws;
    for (long i = (long)c.bx * 512 + c.tid; i < N; i += (long)G * 512) { float a = P.out[i];
      for (long e = i; e < NB16; e += N) a += __uint_as_float(((unsigned)wb[e]) << 16);
      if (i < (long)(3 * MiB)) a += misc[i];
      P.out[i] = a; } }
#else
  { const Params P = load_params(); phase_final(P, c); }
#endif
}

extern "C" void kernel_launch(void* const* d_in, const int* in_sizes, int n_in, void* d_out, int out_size, void* d_ws, size_t ws_size, hipStream_t stream) {
  static int grid_blocks = 0;
  if (!grid_blocks) {
    if (n_in != 26 || out_size != MX * DM || ws_size < WS_END) { fprintf(stderr, "kernel_launch: unexpected shapes / workspace (%d inputs, out %d, ws %zu < %zu)\n", n_in, out_size, ws_size, (size_t)WS_END); grid_blocks = -1; return; }
    int dev = 0, cus = 0, per_cu = 0;
    (void)hipGetDevice(&dev);
    (void)hipDeviceGetAttribute(&cus, hipDeviceAttributeMultiprocessorCount, dev);
    if (hipFuncSetAttribute((const void*)mk_fwd, hipFuncAttributeMaxDynamicSharedMemorySize, LDS_BYTES) != hipSuccess) { fprintf(stderr, "hipFuncSetAttribute failed\n"); grid_blocks = -1; return; }
    (void)hipOccupancyMaxActiveBlocksPerMultiprocessor(&per_cu, (const void*)mk_fwd, 512, LDS_BYTES);
    (void)hipGetLastError();
    grid_blocks = cus;
  }
  if (grid_blocks < 0) return;
  if (hipMemsetAsync(d_ws, 0, 1024, stream) != hipSuccess) { fprintf(stderr, "memset of barrier words failed\n"); return; }
  Params p{};
  const float** pp = (const float**)&p;
  for (int i = 0; i < 26; ++i) pp[i] = (const float*)d_in[i];
  p.out = (float*)d_out; p.ws = (unsigned char*)d_ws; p.ph_lo = 0; p.ph_hi = 1000;
  void* args[] = {&p};
  hipError_t e = hipLaunchCooperativeKernel((void*)mk_fwd, dim3(grid_blocks), dim3(512), args, LDS_BYTES, stream);
  if (e != hipSuccess) fprintf(stderr, "cooperative launch failed: %s (grid %d)\n", hipGetErrorString(e), grid_blocks);
}
```

```cpp
#include <hip/hip_runtime.h>
#include <hip/hip_cooperative_groups.h>
#include <cstdio>
#include <cstdint>
namespace cg = cooperative_groups;

#define LAS __attribute__((address_space(3)))
typedef unsigned short bf16_t;
typedef short bf16x8 __attribute__((ext_vector_type(8)));
typedef short s16x4 __attribute__((ext_vector_type(4)));
typedef float f32x4 __attribute__((ext_vector_type(4)));
typedef float f32x2 __attribute__((ext_vector_type(2)));
typedef float f32x16 __attribute__((ext_vector_type(16)));
typedef unsigned u32x4 __attribute__((ext_vector_type(4)));
typedef unsigned u32x2 __attribute__((ext_vector_type(2)));

constexpr int DM = 2048, NB = 4, SEQ = 4096, CTXL = 256;
constexpr int MX = NB * SEQ, MC = NB * CTXL, MT = MX + MC;
constexpr int KVS = SEQ + CTXL;
constexpr int F_END = 1024, C_END = 3072, Q_END = 3840, KV_END = 4352, KPE_END = 4416, IN_COLS = 10560;
constexpr int FFH = 5632;
constexpr float EPS = 1e-6f;

struct Params {
  const float *x, *c, *ctx, *c_ctx, *ada_w, *ada_b, *norm_mix_g, *w_in, *b_gate, *w_fourier, *conv_w, *conv_b, *conv_ln_g, *conv_ln_b,
      *w_conv_out, *q_norm_g, *w_uq, *kv_norm_g, *w_ukv, *w_mla_o, *w_out, *norm_ffn_g, *w_ffn_gate, *w_ffn_up, *w_ffn_down, *final_norm_g;
  float* out; unsigned char* ws; int ph_lo, ph_hi;
};

typedef const __attribute__((address_space(4))) Params* KArgP;
__device__ __forceinline__ KArgP kargs() { KArgP q = (KArgP)__builtin_amdgcn_kernarg_segment_ptr(); asm volatile("" : "+s"(q)); return q; }

constexpr size_t MiB = 1u << 20;
constexpr size_t WS_FLAGS = 0, WS_SSQQ = 64 * 1024, WS_SSQKV = 192 * 1024, WS_MODS = 512 * 1024, WS_ROPEC = 1 * MiB, WS_ROPES = 1 * MiB + 512 * 1024,
                 WS_CS1 = 2 * MiB, WS_DFTC = 2 * MiB + 256 * 1024,
                 WS_FFTA = 2 * MiB + 512 * 1024, WS_FFTC = WS_FFTA + 64 * 1024, WS_TWC = WS_FFTC + 64 * 1024, WS_TWS = WS_TWC + 16 * 1024;
constexpr size_t WS_CTXX = 4 * MiB, WS_GP = 12 * MiB;
constexpr size_t WS_WIN = 76 * MiB, WS_WF = 118 * MiB, WS_WC = 122 * MiB, WS_WUQ = 126 * MiB, WS_WUKV = 131 * MiB, WS_WMLA = 135 * MiB, WS_WOUT = 143 * MiB,
                 WS_WGU = 151 * MiB, WS_WDN = 195 * MiB;
constexpr size_t WS_H = 217 * MiB, WS_Q = 285 * MiB, WS_TMPG = 285 * MiB, WS_HID = 285 * MiB, WS_KN = 387 * MiB, WS_MERGED = 387 * MiB, WS_V = 455 * MiB,
                 WS_ZT = 523 * MiB, WS_ZTC = 587 * MiB, WS_CBF = 591 * MiB, WS_KPE = 625 * MiB, WS_UF = 628 * MiB, WS_O = 628 * MiB, WS_VB = 662 * MiB,
                 WS_QD = 696 * MiB, WS_F = 696 * MiB, WS_KVD = 722 * MiB, WS_GATEC = 739 * MiB, WS_YC = 751 * MiB, WS_PART = 763 * MiB, WS_END = 795 * MiB;

typedef __bf16 bf16x2_t __attribute__((ext_vector_type(2)));
__device__ __forceinline__ unsigned cvt_pk(float lo, float hi) { f32x2 v = {lo, hi}; bf16x2_t b = __builtin_convertvector(v, bf16x2_t); return __builtin_bit_cast(unsigned, b); }
__device__ __forceinline__ int opaque(int v) { asm volatile("" : "+v"(v)); return v; }
__device__ __forceinline__ float bflo(unsigned w) { return __uint_as_float(w << 16); }
__device__ __forceinline__ float bfhi(unsigned w) { return __uint_as_float(w & 0xffff0000u); }
__device__ __forceinline__ float fsigmoid(float x) { return __builtin_amdgcn_rcpf(1.f + __expf(-x)); }
__device__ __forceinline__ float wave_sum(float v) {
#pragma unroll
  for (int o = 1; o < 64; o <<= 1) v += __shfl_xor(v, o);
  return v;
}
__device__ __forceinline__ u32x4 pack8(f32x4 a, f32x4 b) { u32x4 w; w.x = cvt_pk(a[0], a[1]); w.y = cvt_pk(a[2], a[3]); w.z = cvt_pk(b[0], b[1]); w.w = cvt_pk(b[2], b[3]); return w; }
__device__ __forceinline__ int kvrow(int row) { return row < MX ? (row >> 12) * KVS + (row & 4095) : ((row - MX) >> 8) * KVS + SEQ + ((row - MX) & 255); }
__device__ __forceinline__ int modgrp(int row) { return row < MX ? (row >> 12) : 4; }

namespace pg8 {
constexpr int BM = 256, BK = 64, HALF = 128, HTB = HALF * BK * 2, STAGE_BYTES = 8 * HTB, NXCD = 8, WGM = 8;
__host__ __device__ __forceinline__ int lds_byte(int r, int c) { const int st = (r >> 4) * 2 + (c >> 5), rr = r & 15, cc = c & 31, ob = rr * 64 + cc * 2; return st * 1024 + (ob ^ (((ob >> 9) & 1) << 5)); }
__host__ __device__ __forceinline__ void stage_rc(int b, int& R, int& C) { const int st = b / 1024, sb = b % 1024, swz = sb ^ (((sb >> 9) & 1) << 5); R = (st >> 1) * 16 + swz / 64; C = (st & 1) * 32 + (swz % 64) / 2; }
__host__ __device__ __forceinline__ int perm32(int rho) { const int n = rho >> 4, i = rho & 15; return 8 * (i >> 2) + 4 * n + (i & 3); }
struct Unit { int pm, pn; };
struct Order {
  int nM, nN, nwg, G, c;
  __device__ void init(int nM_, int nN_, int G_, int c_) { nM = nM_; nN = nN_; nwg = nM * nN; G = G_; c = c_; }
  __device__ bool next(int i, Unit& u) const {
    const long L = (long)i * G + c; if (L >= nwg) return false;
    int wgid = (int)L; { const int q = nwg / NXCD, r = nwg % NXCD, xcd = wgid % NXCD, off = wgid / NXCD; wgid = (xcd < r ? xcd * (q + 1) : r * (q + 1) + (xcd - r) * q) + off; }
    const int nig = WGM * nN, gid = wgid / nig, fm = gid * WGM, gsz = (nM - fm) < WGM ? (nM - fm) : WGM;
    u.pm = fm + ((wgid % nig) % gsz); u.pn = (wgid % nig) / gsz; return true;
  }
};
enum { GEO_STD = 0, GEO_DFT1 = 1, GEO_DFT2 = 2, GEO_SPLITK = 3, GEO_A0 = 4 };
struct Geo {
  int mode; int lda, ldb; int aux;
  __device__ __forceinline__ size_t aoff(const Unit& u) const { if (mode == GEO_SPLITK) return (size_t)u.pm * BM * lda * 2 + (size_t)(u.pn >> 3) * aux * 2;
    return (mode == GEO_DFT1 || mode == GEO_A0) ? 0 : (size_t)u.pm * BM * lda * 2; }
  __device__ __forceinline__ size_t boff(const Unit& u) const {
    if (mode == GEO_STD) return (size_t)u.pn * BM * ldb * 2;
    if (mode == GEO_SPLITK) return (size_t)(u.pn & 7) * BM * ldb * 2 + (size_t)(u.pn >> 3) * aux * 2;
    if (mode == GEO_A0) return (size_t)u.pn * BM * ldb * 2;
    if (mode == GEO_DFT1) { const int tp = aux ? 1 : 16, seqlen = aux ? CTXL : SEQ; const int bg = u.pn / tp, pt = u.pn % tp, b = bg >> 3, g = bg & 7;
      return ((size_t)(b * seqlen + pt * (aux ? 256 : 4)) * 1024 + g * 128) * 2; }
    const int zl = aux ? 512 : 8192; const int b = u.pn >> 2, ct = u.pn & 3; return ((size_t)(b * 1024 + ct * 256) * zl) * 2;
  }
};

enum { E_IN = 0, E_DFT1, E_UQ, E_UKV, E_DFT2, E_GATE, E_Y, E_RES, E_UP, E_YC, E_FFTA, E_FFTC };
struct Epi {
  int mode; int pm_off, pn_off; int aux; int l; unsigned char* ws;
  __device__ __forceinline__ void operator()(const f32x4 (&acc)[2][2][4][2], const Unit& u, int wr, int wc, int fr_in, int fq_in) const {
    const int fr = opaque(fr_in), fq = opaque(fq_in);
    bf16_t *o0 = nullptr, *o1 = nullptr, *o2 = nullptr, *o3 = nullptr, *o4 = nullptr; const bf16_t* g0 = nullptr; float *s0 = nullptr, *s1 = nullptr; const float *c0 = nullptr, *c1 = nullptr;
    const float *xin_l = nullptr, *xin_c = nullptr; float *xout_l = nullptr, *xout_c = nullptr; int first = 0, seqlen = 0, tp = 1, zl = 0, rowbase = 0;
    switch (mode) {
      case E_IN: o0 = (bf16_t*)(ws + WS_UF); o1 = (bf16_t*)(ws + WS_VB); o2 = (bf16_t*)(ws + WS_QD); o3 = (bf16_t*)(ws + WS_KVD); o4 = (bf16_t*)(ws + WS_KPE);
        s0 = (float*)(ws + WS_SSQQ); s1 = (float*)(ws + WS_SSQKV); c0 = (const float*)(ws + WS_ROPEC); c1 = (const float*)(ws + WS_ROPES); break;
      case E_DFT1: o0 = (bf16_t*)(ws + (aux ? WS_ZTC : WS_ZT)); tp = aux ? 1 : 16; zl = aux ? 512 : 8192; break;
      case E_UQ: o0 = (bf16_t*)(ws + WS_Q); s0 = (float*)(ws + WS_SSQQ); c0 = (const float*)(ws + WS_ROPEC); c1 = (const float*)(ws + WS_ROPES); break;
      case E_UKV: o0 = (bf16_t*)(ws + WS_KN); o1 = (bf16_t*)(ws + WS_V); s1 = (float*)(ws + WS_SSQKV); break;
      case E_FFTA: o0 = (bf16_t*)(ws + WS_GP); c0 = (const float*)(ws + WS_TWC); c1 = (const float*)(ws + WS_TWS); break;
      case E_FFTC: o0 = (bf16_t*)(ws + WS_F); break;
      case E_DFT2: o0 = (bf16_t*)(ws + WS_F); seqlen = aux ? CTXL : SEQ; rowbase = aux ? MX : 0; break;
      case E_GATE: o0 = (aux & 4) ? (bf16_t*)(ws + WS_GATEC) + (size_t)(aux & 3) * 1024 * 2048 - (size_t)MX * 2048 : (bf16_t*)(ws + WS_TMPG); c0 = kargs()->b_gate + (size_t)l * 6144 + (aux & 3) * 2048; break;
      case E_YC: o0 = (bf16_t*)(ws + WS_YC) + (size_t)aux * 1024 * 2048 - (size_t)MX * 2048; break;
      case E_Y: o0 = (bf16_t*)(ws + WS_MERGED); g0 = (const bf16_t*)(ws + WS_TMPG); first = aux; break;
      case E_RES: { KArgP ka = kargs(); float* outp = ka->out; float* cx = (float*)(ws + WS_CTXX); const bool fresh = ((aux & 1) == 0 && l == 0);
        c0 = (const float*)(ws + WS_MODS) + (size_t)l * 5 * 12288 + ((aux & 1) ? 5 : 2) * 2048; xin_l = fresh ? ka->x : outp; xin_c = fresh ? ka->ctx : cx; xout_l = outp; xout_c = cx; break; }
      default: o0 = (bf16_t*)(ws + WS_HID); break;
    }
    const int pm = u.pm + pm_off, pn = u.pn + pn_off;
    const int cin = 32 * wc + 8 * fq;
    if (mode == E_IN) {
      if (pn < 4) {
#pragma unroll
        for (int ai = 0; ai < 2; ++ai)
#pragma unroll
          for (int m = 0; m < 4; ++m) { const int row = pm * 256 + ai * 128 + wr * 64 + m * 16 + fr;
#pragma unroll
            for (int bj = 0; bj < 2; ++bj) *(u32x4*)(o0 + (size_t)row * 1024 + pn * 256 + bj * 128 + cin) = pack8(acc[ai][bj][m][0], acc[ai][bj][m][1]); }
      } else if (pn < 12) {
        const int t = pn - 4;
#pragma unroll
        for (int ai = 0; ai < 2; ++ai)
#pragma unroll
          for (int m = 0; m < 4; ++m) { const int row = pm * 256 + ai * 128 + wr * 64 + m * 16 + fr;
            f32x4 v0, v1;
#pragma unroll
            for (int j = 0; j < 4; ++j) { v0[j] = acc[ai][0][m][0][j] * fsigmoid(acc[ai][1][m][0][j]); v1[j] = acc[ai][0][m][1][j] * fsigmoid(acc[ai][1][m][1][j]); }
            *(u32x4*)(o1 + (size_t)row * 1024 + t * 128 + cin) = pack8(v0, v1); }
      } else if (pn < 17) {
        const bool isq = pn < 15; bf16_t* ob = isq ? o2 : o3; const int ld = isq ? 768 : 512; const int ct = isq ? pn - 12 : pn - 15; float* ssq = isq ? s0 : s1;
#pragma unroll
        for (int ai = 0; ai < 2; ++ai)
#pragma unroll
          for (int m = 0; m < 4; ++m) { const int row = pm * 256 + ai * 128 + wr * 64 + m * 16 + fr; float s = 0.f;
#pragma unroll
            for (int bj = 0; bj < 2; ++bj) { const f32x4 a = acc[ai][bj][m][0], b = acc[ai][bj][m][1];
              s += (a[0] * a[0] + a[1] * a[1]) + (a[2] * a[2] + a[3] * a[3]) + (b[0] * b[0] + b[1] * b[1]) + (b[2] * b[2] + b[3] * b[3]);
              *(u32x4*)(ob + (size_t)row * ld + ct * 256 + bj * 128 + cin) = pack8(a, b); }
            s += __shfl_xor(s, 16); s += __shfl_xor(s, 32);
            if (fq == 0) atomicAdd(ssq + row, s); }
      } else {
        if (wc == 0) {
#pragma unroll
          for (int ai = 0; ai < 2; ++ai)
#pragma unroll
            for (int m = 0; m < 4; ++m) { const int row = pm * 256 + ai * 128 + wr * 64 + m * 16 + fr;
              f32x4 x1a = acc[ai][0][m][0], x1b = acc[ai][0][m][1], x2a = acc[ai][1][m][0], x2b = acc[ai][1][m][1], y1a = x1a, y1b = x1b, y2a = x2a, y2b = x2b;
              if (row < MX) { const int pos = row & 4095; const f32x4 ca = *(const f32x4*)(c0 + pos * 32 + cin), cb = *(const f32x4*)(c0 + pos * 32 + cin + 4), sa = *(const f32x4*)(c1 + pos * 32 + cin), sb = *(const f32x4*)(c1 + pos * 32 + cin + 4);
                y1a = x1a * ca - x2a * sa; y1b = x1b * cb - x2b * sb; y2a = x1a * sa + x2a * ca; y2b = x1b * sb + x2b * cb; }
              const int kr = kvrow(row);
              *(u32x4*)(o4 + (size_t)kr * 64 + cin) = pack8(y1a, y1b); *(u32x4*)(o4 + (size_t)kr * 64 + 32 + cin) = pack8(y2a, y2b); }
        }
      }
    } else if (mode == E_FFTA) {
      if (true) {
#pragma unroll
        for (int m2 = 0; m2 < 2; ++m2) { const int k1 = 32 * wr + 16 * m2 + fr;
#pragma unroll
          for (int bj = 0; bj < 2; ++bj) { const int nu = pn * 256 + bj * 128 + cin, n2 = nu & 63, chb = nu >> 6, ch = chb & 1023, b = chb >> 10;
            const f32x4 ca = *(const f32x4*)(c0 + k1 * 64 + n2), cb = *(const f32x4*)(c0 + k1 * 64 + n2 + 4), sa = *(const f32x4*)(c1 + k1 * 64 + n2), sb = *(const f32x4*)(c1 + k1 * 64 + n2 + 4);
            const f32x4 ra = acc[0][bj][m2][0], rb = acc[0][bj][m2][1], ia = acc[0][bj][m2 + 2][0], ib = acc[0][bj][m2 + 2][1];
            bf16_t* dst = o0 + ((size_t)((b * 64 + k1) * 1024 + ch)) * 128 + n2;
            *(u32x4*)dst = pack8(ra * ca + ia * sa, rb * cb + ib * sb); *(u32x4*)(dst + 64) = pack8(ia * ca - ra * sa, ib * cb - rb * sb); } }
      }
    } else if (mode == E_FFTC) {
      if (wr == 0) {
#pragma unroll
        for (int m = 0; m < 4; ++m) { const int k2 = 16 * m + fr;
#pragma unroll
          for (int bj = 0; bj < 2; ++bj) { const int nu = pn * 256 + bj * 128 + cin, ch = nu & 1023, k1 = (nu >> 10) & 63, b = nu >> 16;
            *(u32x4*)(o0 + ((size_t)(b * 4096 + k1 + 64 * k2)) * 1024 + ch) = pack8(acc[0][bj][m][0], acc[0][bj][m][1]); } }
      }
    } else if (mode == E_DFT1 && aux == 0) {
      const int bg = pn >> 4, pt = pn & 15, b = bg >> 3, g = bg & 7;
#pragma unroll
      for (int ai = 0; ai < 2; ++ai)
#pragma unroll
        for (int m = 0; m < 4; ++m) { const int l = wr * 64 + m * 16 + fr;
#pragma unroll
          for (int bj = 0; bj < 2; ++bj) { const int cl = bj * 128 + cin, n2 = 4 * pt + (cl >> 6), n1 = cl & 63;
            *(u32x4*)(o0 + ((size_t)((b * 1024 + g * 128 + l) * 64 + n2)) * 128 + ai * 64 + n1) = pack8(acc[ai][bj][m][0], acc[ai][bj][m][1]); } }
    } else if (mode == E_DFT1) {
      const int bg = pn / tp, pt = pn % tp, b = bg >> 3, g = bg & 7;
#pragma unroll
      for (int ai = 0; ai < 2; ++ai)
#pragma unroll
        for (int m = 0; m < 4; ++m) { const int l = wr * 64 + m * 16 + fr;
#pragma unroll
          for (int bj = 0; bj < 2; ++bj) *(u32x4*)(o0 + (size_t)(b * 1024 + g * 128 + l) * zl + ai * (zl >> 1) + pt * 256 + bj * 128 + cin) = pack8(acc[ai][bj][m][0], acc[ai][bj][m][1]); }
    } else if (mode == E_UQ) {
#pragma unroll
      for (int ai = 0; ai < 2; ++ai)
#pragma unroll
        for (int m = 0; m < 4; ++m) { const int row = pm * 256 + ai * 128 + wr * 64 + m * 16 + fr; const float rs = 1.0f / sqrtf(s0[row] * (1.f / 768.f) + EPS);
          if (pn < 8) {
#pragma unroll
            for (int bj = 0; bj < 2; ++bj) *(u32x4*)(o0 + (size_t)row * 3072 + (2 * pn + bj) * 192 + cin) = pack8(acc[ai][bj][m][0] * rs, acc[ai][bj][m][1] * rs);
          } else {
            const int head = 4 * (pn - 8) + wc, i0 = 8 * fq;
            f32x4 x1a = acc[ai][0][m][0] * rs, x1b = acc[ai][0][m][1] * rs, x2a = acc[ai][1][m][0] * rs, x2b = acc[ai][1][m][1] * rs, y1a = x1a, y1b = x1b, y2a = x2a, y2b = x2b;
            if (row < MX) { const int pos = row & 4095; const f32x4 ca = *(const f32x4*)(c0 + pos * 32 + i0), cb = *(const f32x4*)(c0 + pos * 32 + i0 + 4), sa = *(const f32x4*)(c1 + pos * 32 + i0), sb = *(const f32x4*)(c1 + pos * 32 + i0 + 4);
              y1a = x1a * ca - x2a * sa; y1b = x1b * cb - x2b * sb; y2a = x1a * sa + x2a * ca; y2b = x1b * sb + x2b * cb; }
            *(u32x4*)(o0 + (size_t)row * 3072 + head * 192 + 128 + i0) = pack8(y1a, y1b); *(u32x4*)(o0 + (size_t)row * 3072 + head * 192 + 160 + i0) = pack8(y2a, y2b);
          } }
    } else if (mode == E_UKV) {
      bf16_t* ob = pn < 8 ? o0 : o1; const int ct = pn < 8 ? pn : pn - 8;
#pragma unroll
      for (int ai = 0; ai < 2; ++ai)
#pragma unroll
        for (int m = 0; m < 4; ++m) { const int row = pm * 256 + ai * 128 + wr * 64 + m * 16 + fr; const float rs = 1.0f / sqrtf(s1[row] * (1.f / 512.f) + EPS); const int kr = kvrow(row);
#pragma unroll
          for (int bj = 0; bj < 2; ++bj) *(u32x4*)(ob + (size_t)kr * 2048 + ct * 256 + bj * 128 + cin) = pack8(acc[ai][bj][m][0] * rs, acc[ai][bj][m][1] * rs); }
    } else if (mode == E_DFT2) {
      const int b = pn >> 2, ct = pn & 3;
#pragma unroll
      for (int ai = 0; ai < 2; ++ai)
#pragma unroll
        for (int m = 0; m < 4; ++m) { const int row = rowbase + b * seqlen + pm * 256 + ai * 128 + wr * 64 + m * 16 + fr;
#pragma unroll
          for (int bj = 0; bj < 2; ++bj) *(u32x4*)(o0 + (size_t)row * 1024 + ct * 256 + bj * 128 + cin) = pack8(acc[ai][bj][m][0], acc[ai][bj][m][1]); }
    } else if (mode == E_GATE) {
#pragma unroll
      for (int bj = 0; bj < 2; ++bj) { const int col = pn * 256 + bj * 128 + cin; const f32x4 ba = *(const f32x4*)(c0 + col), bb = *(const f32x4*)(c0 + col + 4);
#pragma unroll
        for (int ai = 0; ai < 2; ++ai)
#pragma unroll
          for (int m = 0; m < 4; ++m) { const int row = pm * 256 + ai * 128 + wr * 64 + m * 16 + fr; f32x4 v0, v1;
#pragma unroll
            for (int j = 0; j < 4; ++j) { v0[j] = fsigmoid(acc[ai][bj][m][0][j] + ba[j]); v1[j] = fsigmoid(acc[ai][bj][m][1][j] + bb[j]); }
            *(u32x4*)(o0 + (size_t)row * 2048 + col) = pack8(v0, v1); } }
    } else if (mode == E_Y) {
#pragma unroll
      for (int am = 0; am < 4; ++am) { const int ai = am >> 1, mb = (am & 1) * 2; u32x4 gw[2][2], mw[2][2];
#pragma unroll
        for (int mm = 0; mm < 2; ++mm)
#pragma unroll
          for (int bj = 0; bj < 2; ++bj) { const int row = pm * 256 + ai * 128 + wr * 64 + (mb + mm) * 16 + fr; const size_t off = (size_t)row * 2048 + pn * 256 + bj * 128 + cin;
            gw[mm][bj] = *(const u32x4*)(g0 + off); mw[mm][bj] = first ? (u32x4){0u, 0u, 0u, 0u} : *(const u32x4*)(o0 + off); }
        asm volatile("" ::: "memory");
#pragma unroll
        for (int mm = 0; mm < 2; ++mm)
#pragma unroll
          for (int bj = 0; bj < 2; ++bj) { const int m = mb + mm; const int row = pm * 256 + ai * 128 + wr * 64 + m * 16 + fr; const size_t off = (size_t)row * 2048 + pn * 256 + bj * 128 + cin; const u32x4 g_ = gw[mm][bj], m_ = mw[mm][bj];
            f32x4 v0, v1; v0[0] = bflo(g_.x) * acc[ai][bj][m][0][0] + bflo(m_.x); v0[1] = bfhi(g_.x) * acc[ai][bj][m][0][1] + bfhi(m_.x); v0[2] = bflo(g_.y) * acc[ai][bj][m][0][2] + bflo(m_.y); v0[3] = bfhi(g_.y) * acc[ai][bj][m][0][3] + bfhi(m_.y);
            v1[0] = bflo(g_.z) * acc[ai][bj][m][1][0] + bflo(m_.z); v1[1] = bfhi(g_.z) * acc[ai][bj][m][1][1] + bfhi(m_.z); v1[2] = bflo(g_.w) * acc[ai][bj][m][1][2] + bflo(m_.w); v1[3] = bfhi(g_.w) * acc[ai][bj][m][1][3] + bfhi(m_.w);
            *(u32x4*)(o0 + off) = pack8(v0, v1); }
        asm volatile("" ::: "memory"); }
    } else if (mode == E_YC) {
#pragma unroll
      for (int ai = 0; ai < 2; ++ai)
#pragma unroll
        for (int m = 0; m < 4; ++m) { const int row = pm * 256 + ai * 128 + wr * 64 + m * 16 + fr;
#pragma unroll
          for (int bj = 0; bj < 2; ++bj) *(u32x4*)(o0 + (size_t)row * 2048 + pn * 256 + bj * 128 + cin) = pack8(acc[ai][bj][m][0], acc[ai][bj][m][1]); }
    } else if (mode == E_RES) {
      if (aux & 8) {
        float* pb = (float*)(ws + WS_PART) + (size_t)(pn >> 3) * 1024 * 2048; const int pnn = pn & 7;
#pragma unroll
        for (int ai = 0; ai < 2; ++ai)
#pragma unroll
          for (int m = 0; m < 4; ++m) { const int row = pm * 256 + ai * 128 + wr * 64 + m * 16 + fr - MX;
#pragma unroll
            for (int bj = 0; bj < 2; ++bj) { float* q = pb + (size_t)row * 2048 + pnn * 256 + bj * 128 + cin; *(f32x4*)q = acc[ai][bj][m][0]; *(f32x4*)(q + 4) = acc[ai][bj][m][1]; } }
        return;
      }
      {
        const int row0 = pm * 256; const bool lat = row0 < MX; const int mg = modgrp(row0);
        const float* xi0 = lat ? xin_l + (size_t)row0 * 2048 : xin_c + (size_t)(row0 - MX) * 2048; float* xo0 = lat ? xout_l + (size_t)row0 * 2048 : xout_c + (size_t)(row0 - MX) * 2048;
        f32x4 ga[2], gb[2];
#pragma unroll
        for (int bj = 0; bj < 2; ++bj) { const int col = pn * 256 + bj * 128 + cin; ga[bj] = *(const f32x4*)(c0 + mg * 12288 + col); gb[bj] = *(const f32x4*)(c0 + mg * 12288 + col + 4); }
#pragma unroll
        for (int am = 0; am < 4; ++am) { const int ai = am >> 1, mb = (am & 1) * 2; f32x4 xa[2][2], xb[2][2];
#pragma unroll
          for (int mm = 0; mm < 2; ++mm)
#pragma unroll
            for (int bj = 0; bj < 2; ++bj) { const size_t off = (size_t)(ai * 128 + wr * 64 + (mb + mm) * 16 + fr) * 2048 + pn * 256 + bj * 128 + cin; xa[mm][bj] = *(const f32x4*)(xi0 + off); xb[mm][bj] = *(const f32x4*)(xi0 + off + 4); }
          asm volatile("" ::: "memory");
#pragma unroll
          for (int mm = 0; mm < 2; ++mm)
#pragma unroll
            for (int bj = 0; bj < 2; ++bj) { const size_t off = (size_t)(ai * 128 + wr * 64 + (mb + mm) * 16 + fr) * 2048 + pn * 256 + bj * 128 + cin;
              *(f32x4*)(xo0 + off) = xa[mm][bj] + ga[bj] * acc[ai][bj][mb + mm][0]; *(f32x4*)(xo0 + off + 4) = xb[mm][bj] + gb[bj] * acc[ai][bj][mb + mm][1]; }
          asm volatile("" ::: "memory"); }
      }
    } else {
#pragma unroll
      for (int ai = 0; ai < 2; ++ai)
#pragma unroll
        for (int m = 0; m < 4; ++m) { const int row = pm * 256 + ai * 128 + wr * 64 + m * 16 + fr; f32x4 v0, v1;
#pragma unroll
          for (int j = 0; j < 4; ++j) { const float a = acc[ai][0][m][0][j], b = acc[ai][0][m][1][j]; v0[j] = a * fsigmoid(a) * acc[ai][1][m][0][j]; v1[j] = b * fsigmoid(b) * acc[ai][1][m][1][j]; }
          *(u32x4*)(o0 + (size_t)row * FFH + pn * 128 + cin) = pack8(v0, v1); }
    }
  }
};

__device__ __forceinline__ void gemm_phase(LAS unsigned char* lds, const bf16_t* Aop, const bf16_t* Bop, int K, const Order& S, const Geo& geo, const Epi& E) {
  const int tid = opaque(threadIdx.x), wid = __builtin_amdgcn_readfirstlane(tid >> 6), lane = tid & 63, wr = wid >> 2, wc = wid & 3, fr = lane & 15, fq = lane >> 4;
  const int nt = K / BK;
  unsigned voffA[2], voffB[2];
  const bool rperm = (geo.mode == GEO_DFT1 && geo.aux == 0);
#pragma unroll
  for (int i = 0; i < 2; ++i) { int R, C; stage_rc(tid * 16 + i * 8192, R, C); const int Rb = (R & ~31) + perm32(R & 31); const int Rg = rperm ? 64 * (Rb & 63) + (Rb >> 6) : Rb;
    voffA[i] = (unsigned)(R * geo.lda + C) * 2u; voffB[i] = (unsigned)(Rg * geo.ldb + C) * 2u; }
  const size_t kstep = (size_t)(BK * 2);
  const size_t hstepA = (size_t)HALF * geo.lda * 2, hstepB = rperm ? (size_t)2 * geo.ldb * 2 : (size_t)HALF * geo.ldb * 2;
  const unsigned ldsw = (unsigned)wid * 1024u;
  const int aoff = lds_byte(wr * 64 + fr, fq * 8), boff = lds_byte(wc * 32 + fr, fq * 8);
#define PG8_SA(b, h) (((b) * 2 + (h)) * HTB)
#define PG8_SB(b, h) ((4 + (b) * 2 + (h)) * HTB)
#define PG8_STAGE(bufoff, gbase, voff) do { _Pragma("unroll") for (int _i = 0; _i < 2; ++_i) \
        __builtin_amdgcn_global_load_lds((const unsigned*)((const char*)(gbase) + (voff)[_i]), (LAS unsigned*)(lds + (bufoff) + ldsw + _i * 8192), 16, 0, 0); } while (0)
#define PG8_LDA(dst, b, h) do { _Pragma("unroll") for (int m = 0; m < 4; ++m) _Pragma("unroll") for (int k = 0; k < 2; ++k) dst[m][k] = *(const LAS bf16x8*)(lds + PG8_SA(b, h) + aoff + m * 2048 + k * 1024); } while (0)
#define PG8_LDB(dst, b, h) do { _Pragma("unroll") for (int n = 0; n < 2; ++n) _Pragma("unroll") for (int k = 0; k < 2; ++k) dst[n][k] = *(const LAS bf16x8*)(lds + PG8_SB(b, h) + boff + n * 2048 + k * 1024); } while (0)
#define PG8_MMA(ai, bj, At, Bt) do { __builtin_amdgcn_s_setprio(1); _Pragma("unroll") for (int m = 0; m < 4; ++m) _Pragma("unroll") for (int n = 0; n < 2; ++n) _Pragma("unroll") for (int k = 0; k < 2; ++k) \
        acc[ai][bj][m][n] = __builtin_amdgcn_mfma_f32_16x16x32_bf16(Bt[n][k], At[m][k], acc[ai][bj][m][n], 0, 0, 0); __builtin_amdgcn_s_setprio(0); } while (0)
#define PG8_WAIT_V(n) asm volatile("s_waitcnt vmcnt(" #n ")" ::: "memory")
#define PG8_WAIT_L(n) asm volatile("s_waitcnt lgkmcnt(" #n ")" ::: "memory")
#define PG8_BAR __builtin_amdgcn_s_barrier()
#define PG8_SCHED __builtin_amdgcn_sched_barrier(0)
  Unit cur, nxt; int ui = 0;
  if (!S.next(0, cur)) return;
  f32x4 acc[2][2][4][2];
#pragma unroll
  for (int a = 0; a < 2; ++a)
#pragma unroll
    for (int b = 0; b < 2; ++b)
#pragma unroll
      for (int m = 0; m < 4; ++m)
#pragma unroll
        for (int n = 0; n < 2; ++n) acc[a][b][m][n] = (f32x4){0.f, 0.f, 0.f, 0.f};
  bf16x8 At[4][2], B0[2][2], B1[2][2];
  const char* cA = (const char*)Aop + geo.aoff(cur); const char* cB = (const char*)Bop + geo.boff(cur);
  PG8_STAGE(PG8_SB(0, 0), cB, voffB); PG8_STAGE(PG8_SB(0, 1), cB + hstepB, voffB); PG8_STAGE(PG8_SA(0, 0), cA, voffA); PG8_STAGE(PG8_SA(0, 1), cA + hstepA, voffA);
  if (wr == 1) PG8_BAR;
  PG8_WAIT_V(2); PG8_BAR;
  PG8_STAGE(PG8_SB(1, 0), cB + kstep, voffB); PG8_STAGE(PG8_SA(1, 0), cA + kstep, voffA); PG8_STAGE(PG8_SB(1, 1), cB + hstepB + kstep, voffB);
  PG8_WAIT_V(6); PG8_BAR;
  for (;;) {
    const bool has_next = S.next(ui + 1, nxt);
    const char* nA = has_next ? (const char*)Aop + geo.aoff(nxt) : cA; const char* nB = has_next ? (const char*)Bop + geo.boff(nxt) : cB;
    for (int t = 0; t < nt; t += 2) {
      const bool last = (t == nt - 2);
      const char* a1 = cA + (size_t)(t + 1) * kstep;
      const char* a2 = last ? nA : cA + (size_t)(t + 2) * kstep; const char* b2 = last ? nB : cB + (size_t)(t + 2) * kstep;
      const char* a3 = a2 + kstep; const char* b3 = b2 + kstep;
      PG8_LDB(B0, 0, 0); PG8_LDB(B1, 0, 1); PG8_SCHED; PG8_LDA(At, 0, 0); PG8_STAGE(PG8_SA(1, 1), a1 + hstepA, voffA);
      PG8_WAIT_V(8); PG8_WAIT_L(0); PG8_BAR; PG8_MMA(0, 0, At, B0); PG8_MMA(0, 1, At, B1); PG8_BAR; PG8_SCHED;
      PG8_LDA(At, 0, 1); PG8_STAGE(PG8_SB(0, 0), b2, voffB); PG8_STAGE(PG8_SB(0, 1), b2 + hstepB, voffB); PG8_STAGE(PG8_SA(0, 0), a2, voffA);
      PG8_WAIT_V(8); PG8_WAIT_L(0); PG8_BAR; PG8_MMA(1, 0, At, B0); PG8_MMA(1, 1, At, B1); PG8_BAR; PG8_SCHED;
      PG8_LDB(B0, 1, 0); PG8_LDB(B1, 1, 1); PG8_SCHED; PG8_LDA(At, 1, 0); PG8_STAGE(PG8_SA(0, 1), a2 + hstepA, voffA);
      PG8_WAIT_V(8); PG8_WAIT_L(0); PG8_BAR; PG8_MMA(0, 0, At, B0); PG8_MMA(0, 1, At, B1); PG8_BAR; PG8_SCHED;
      PG8_LDA(At, 1, 1); PG8_STAGE(PG8_SB(1, 0), b3, voffB); PG8_STAGE(PG8_SB(1, 1), b3 + hstepB, voffB); PG8_STAGE(PG8_SA(1, 0), a3, voffA);
      PG8_WAIT_V(8); PG8_WAIT_L(0); PG8_BAR; PG8_MMA(1, 0, At, B0); PG8_MMA(1, 1, At, B1); PG8_BAR; PG8_SCHED;
    }
    if (wr == 0) PG8_BAR;
    E(acc, cur, wr, wc, fr, fq);
    if (!has_next) break;
#pragma unroll
    for (int a = 0; a < 2; ++a)
#pragma unroll
      for (int b = 0; b < 2; ++b)
#pragma unroll
        for (int m = 0; m < 4; ++m)
#pragma unroll
          for (int n = 0; n < 2; ++n) acc[a][b][m][n] = (f32x4){0.f, 0.f, 0.f, 0.f};
    cur = nxt; cA = nA; cB = nB; ++ui;
    if (wr == 1) PG8_BAR;
  }
  PG8_WAIT_V(0);
  PG8_BAR;
#undef PG8_SA
#undef PG8_SB
#undef PG8_STAGE
#undef PG8_LDA
#undef PG8_LDB
#undef PG8_MMA
#undef PG8_WAIT_V
#undef PG8_WAIT_L
#undef PG8_BAR
#undef PG8_SCHED
}
}

namespace att {
constexpr int NW = 8, QBLK = 32, KVBLK = 64;
constexpr float SCALE = 0.07216878364870322f;
constexpr float THR = 8.f;
constexpr int SDEPTH = 1;
constexpr int LDQ = 3072, LDK = 2048, LDKP = 64, LDO = 2048;
constexpr int SHM_V = 16384, SHM_K = 16384, SHM_KP = 8192;
constexpr int OFF_V = 0, OFF_K = 2 * SHM_V, OFF_KP = OFF_K + 2 * SHM_K, OFF_WS = OFF_KP + 2 * SHM_KP, OFF_QP = OFF_WS + NW * 64 * 4, QP_WAVE = 32 * 208, SHM_ATTN = OFF_QP + NW * QP_WAVE;
#define KSWZ(row, colB) ((row) * 256 + ((colB) ^ (((row) & 15) << 4)))
#define KPSWZ(row, colB) ((row) * 128 + ((colB) ^ ((((row) >> 1) & 7) << 4)))
#define SBAR() __builtin_amdgcn_sched_barrier(0)
__device__ __forceinline__ int crow(int r, int hi) { return (r & 3) + 8 * (r >> 2) + 4 * hi; }
__device__ __forceinline__ void partialSM(f32x16& p0, f32x16& p1, float& m_reg, float& mn, float& alpha) {
  constexpr float C = SCALE * 1.4426950408889634f;
#define MX3(a, b, c) __builtin_fmaxf(__builtin_fmaxf((a), (b)), (c))
  float ma = MX3(p0[0], p0[1], p1[0]), mb = MX3(p0[2], p0[3], p1[1]); ma = MX3(ma, p1[2], p1[3]);
#pragma unroll
  for (int r = 4; r < 16; r += 4) { ma = MX3(ma, p0[r], p0[r + 1]); mb = MX3(mb, p0[r + 2], p0[r + 3]); ma = MX3(ma, p1[r], p1[r + 1]); mb = MX3(mb, p1[r + 2], p1[r + 3]); }
  float pmax = __builtin_fmaxf(ma, mb);
#undef MX3
  { auto rr = __builtin_amdgcn_permlane32_swap(__float_as_uint(pmax), __float_as_uint(pmax), false, false);
    pmax = fmaxf(__uint_as_float(rr[0]), __uint_as_float(rr[1])); }
  if (__builtin_expect(__all(pmax - m_reg <= THR / SCALE), 1)) { mn = m_reg; alpha = 1.f; }
  else { mn = fmaxf(m_reg, pmax); alpha = __builtin_amdgcn_exp2f((m_reg - mn) * C); m_reg = mn; }
  float mnC = -mn * C;
#pragma unroll
  for (int r = 0; r < 16; ++r) p0[r] = fmaf(p0[r], C, mnC);
#pragma unroll
  for (int r = 0; r < 16; ++r) p1[r] = fmaf(p1[r], C, mnC);
#pragma unroll
  for (int r = 0; r < 16; ++r) p0[r] = __builtin_amdgcn_exp2f(p0[r]);
}
__device__ __forceinline__ void finishSM(f32x16& p0, f32x16& p1, float alpha, float& l_reg, bf16x8& pa0, bf16x8& pa1, bf16x8& pa2, bf16x8& pa3) {
#pragma unroll
  for (int r = 0; r < 16; ++r) p1[r] = __builtin_amdgcn_exp2f(p1[r]);
  float ps0 = 0.f, ps1 = 0.f, ps2 = 0.f, ps3 = 0.f;
#pragma unroll
  for (int r = 0; r < 16; r += 4) { ps0 += p0[r] + p1[r]; ps1 += p0[r + 1] + p1[r + 1]; ps2 += p0[r + 2] + p1[r + 2]; ps3 += p0[r + 3] + p1[r + 3]; }
  float ps = (ps0 + ps1) + (ps2 + ps3);
  { auto rr = __builtin_amdgcn_permlane32_swap(__float_as_uint(ps), __float_as_uint(ps), false, false);
    ps = __uint_as_float(rr[0]) + __uint_as_float(rr[1]); }
  l_reg = l_reg * alpha + ps;
#define PK4(P, BASE, OUT) do { unsigned a0 = cvt_pk(P[BASE + 0], P[BASE + 1]), a1 = cvt_pk(P[BASE + 2], P[BASE + 3]);   \
    unsigned b0 = cvt_pk(P[BASE + 4], P[BASE + 5]), b1 = cvt_pk(P[BASE + 6], P[BASE + 7]);                              \
    auto r0 = __builtin_amdgcn_permlane32_swap(a0, b0, false, false); auto r1 = __builtin_amdgcn_permlane32_swap(a1, b1, false, false); \
    u32x4 w = {r0[0], r1[0], r0[1], r1[1]}; OUT = *reinterpret_cast<bf16x8*>(&w); } while (0)
  PK4(p0, 0, pa0); PK4(p0, 8, pa1); PK4(p1, 0, pa2); PK4(p1, 8, pa3);
#undef PK4
}
__device__ __forceinline__ void qkt(f32x16& p0, f32x16& p1, const char* Ks, const char* KPs, const char* QPs, const bf16x8* qr, int r32, int hi) {
  p0 = f32x16{}; p1 = f32x16{};
  const char* qrow = QPs + r32 * 208 + hi * 16;
#pragma unroll
  for (int d0 = 0; d0 < 8; ++d0) { int cb = (d0 * 16 + hi * 8) * 2;
    bf16x8 b0 = *reinterpret_cast<const bf16x8*>(Ks + KSWZ(r32, cb));
    bf16x8 b1 = *reinterpret_cast<const bf16x8*>(Ks + KSWZ(32 + r32, cb));
    bf16x8 qf; if (d0 < 6) qf = qr[d0]; else qf = *reinterpret_cast<const bf16x8*>(qrow + (d0 - 6) * 32);
    p0 = __builtin_amdgcn_mfma_f32_32x32x16_bf16(b0, qf, p0, 0, 0, 0);
    p1 = __builtin_amdgcn_mfma_f32_32x32x16_bf16(b1, qf, p1, 0, 0, 0); }
#pragma unroll
  for (int d0 = 0; d0 < 4; ++d0) { int cb = (d0 * 16 + hi * 8) * 2;
    bf16x8 b0 = *reinterpret_cast<const bf16x8*>(KPs + KPSWZ(r32, cb));
    bf16x8 b1 = *reinterpret_cast<const bf16x8*>(KPs + KPSWZ(32 + r32, cb));
    bf16x8 qf = *reinterpret_cast<const bf16x8*>(qrow + (d0 + 2) * 32);
    p0 = __builtin_amdgcn_mfma_f32_32x32x16_bf16(b0, qf, p0, 0, 0, 0);
    p1 = __builtin_amdgcn_mfma_f32_32x32x16_bf16(b1, qf, p1, 0, 0, 0); }
}
__device__ __forceinline__ int v_st(int k, int c) { const int kk = (k & ~0xC) | ((k & 4) << 1) | ((k & 8) >> 1); return ((kk >> 3) * 4 + (c >> 5)) * 512 + ((kk & 7) * 32 + (c & 31)) * 2; }
__device__ __forceinline__ int v_rd_base(int lane) { return ((lane & 3) << 3) | (((lane >> 2) & 3) << 6) | (((lane >> 4) & 1) << 5) | (((lane >> 5) & 1) << 8); }
constexpr int v_rd_off(int d0, int ks, int half) { return d0 * 512 + ks * 4096 + half * 2048; }
template <int OFF> __device__ __forceinline__ s16x4 tr_read(int vb) {
  s16x4 r; asm volatile("ds_read_b64_tr_b16 %0, %1 offset:%2" : "=&v"(r) : "v"(vb), "i"(OFF) : "memory"); return r;
}
template <int D0> __device__ __forceinline__ void pv_one(f32x16& od, int vb, bf16x8 pa0, bf16x8 pa1, bf16x8 pa2, bf16x8 pa3) {
  const s16x4 l0 = tr_read<v_rd_off(D0, 0, 0)>(vb), h0 = tr_read<v_rd_off(D0, 0, 1)>(vb), l1 = tr_read<v_rd_off(D0, 1, 0)>(vb), h1 = tr_read<v_rd_off(D0, 1, 1)>(vb);
  const s16x4 l2 = tr_read<v_rd_off(D0, 2, 0)>(vb), h2 = tr_read<v_rd_off(D0, 2, 1)>(vb), l3 = tr_read<v_rd_off(D0, 3, 0)>(vb), h3 = tr_read<v_rd_off(D0, 3, 1)>(vb);
  asm volatile("s_waitcnt lgkmcnt(0)" ::: "memory"); SBAR();
#define PK(L, H) (bf16x8){L[0], L[1], L[2], L[3], H[0], H[1], H[2], H[3]}
  od = __builtin_amdgcn_mfma_f32_32x32x16_bf16(pa0, PK(l0, h0), od, 0, 0, 0);
  od = __builtin_amdgcn_mfma_f32_32x32x16_bf16(pa1, PK(l1, h1), od, 0, 0, 0);
  od = __builtin_amdgcn_mfma_f32_32x32x16_bf16(pa2, PK(l2, h2), od, 0, 0, 0);
  od = __builtin_amdgcn_mfma_f32_32x32x16_bf16(pa3, PK(l3, h3), od, 0, 0, 0);
#undef PK
}
__device__ __forceinline__ void pv_d0(f32x16* o, int vb, bf16x8 pa0, bf16x8 pa1, bf16x8 pa2, bf16x8 pa3) {
  pv_one<0>(o[0], vb, pa0, pa1, pa2, pa3); pv_one<1>(o[1], vb, pa0, pa1, pa2, pa3); pv_one<2>(o[2], vb, pa0, pa1, pa2, pa3); pv_one<3>(o[3], vb, pa0, pa1, pa2, pa3);
}
__device__ __forceinline__ void attn_body(const bf16_t* __restrict__ Qb, const bf16_t* __restrict__ Kh, const bf16_t* __restrict__ KPh, const bf16_t* __restrict__ Vh,
                                          bf16_t* __restrict__ Ob, int seq, char* lds) {
  const int tid = opaque(threadIdx.x), wid = tid >> 6, lane = tid & 63, r32 = lane & 31, hi = lane >> 5;
  char* V_lds = lds + OFF_V; char* K_lds = lds + OFF_K; char* KP_lds = lds + OFF_KP;
  float* ws = (float*)(lds + OFF_WS) + wid * 64; float* li_l = ws; float* al_l = ws + 32;
  float m_reg = -1e30f, l_reg = 0; f32x16 o[4] = {}; bf16x8 qr[6];
  char* QP_lds = lds + OFF_QP + wid * QP_WAVE;
  const bf16_t* Qw = Qb + (long)(wid * QBLK + r32) * LDQ + hi * 8;
#pragma unroll
  for (int d0 = 0; d0 < 6; ++d0) qr[d0] = *reinterpret_cast<const bf16x8*>(Qw + d0 * 16);
#pragma unroll
  for (int d0 = 6; d0 < 12; ++d0) *reinterpret_cast<bf16x8*>(QP_lds + r32 * 208 + hi * 16 + (d0 - 6) * 32) = *reinterpret_cast<const bf16x8*>(Qw + d0 * 16);
  const int sr = tid >> 4, sc = (tid & 15) * 8, vst0 = v_st(sr, sc), vst1 = v_st(32 + sr, sc);
  const int pr = tid >> 3, pc = (tid & 7) * 8;
  const int vb0 = (int)(uintptr_t)V_lds + v_rd_base(lane);
  struct { bf16x8 vs0, vs1, ks0, ks1, kp; } sr_[SDEPTH];
#define SLOAD(i, k0) do { sr_[i].vs0 = *reinterpret_cast<const bf16x8*>(&Vh[(long)((k0) + sr) * LDK + sc]); sr_[i].vs1 = *reinterpret_cast<const bf16x8*>(&Vh[(long)((k0) + 32 + sr) * LDK + sc]); \
    sr_[i].ks0 = *reinterpret_cast<const bf16x8*>(&Kh[(long)((k0) + sr) * LDK + sc]); sr_[i].ks1 = *reinterpret_cast<const bf16x8*>(&Kh[(long)((k0) + 32 + sr) * LDK + sc]); \
    sr_[i].kp = *reinterpret_cast<const bf16x8*>(&KPh[(long)((k0) + pr) * LDKP + pc]); } while (0)
#define SWRITE(b, i) do { *(bf16x8*)(V_lds + (b) * SHM_V + vst0) = sr_[i].vs0;          \
    *(bf16x8*)(V_lds + (b) * SHM_V + vst1) = sr_[i].vs1; int kc = sc * 2;               \
    *(bf16x8*)(K_lds + (b) * SHM_K + KSWZ(sr, kc)) = sr_[i].ks0;                       \
    *(bf16x8*)(K_lds + (b) * SHM_K + KSWZ(32 + sr, kc)) = sr_[i].ks1;                  \
    *(bf16x8*)(KP_lds + (b) * SHM_KP + KPSWZ(pr, pc * 2)) = sr_[i].kp; } while (0)
#define SWAIT() do { if constexpr (SDEPTH == 2) asm volatile("s_waitcnt vmcnt(5)" ::: "memory"); else asm volatile("s_waitcnt vmcnt(0)" ::: "memory"); } while (0)
#define RESC(a) do { if (__any((a) < 1.f)) { if (hi == 0) al_l[r32] = (a); asm volatile("s_waitcnt lgkmcnt(0)" ::: "memory"); \
    _Pragma("unroll") for (int d = 0; d < 4; ++d) _Pragma("unroll") for (int r = 0; r < 16; ++r) o[d][r] *= al_l[crow(r, hi)]; } } while (0)
  f32x16 pA0, pA1, pB0, pB1; float mnA, mnB, alA, alB; bf16x8 pa0, pa1, pa2, pa3; const int NT = seq / KVBLK;
  constexpr int SE = 0, SO = SDEPTH - 1;
  SLOAD(SE, 0); asm volatile("s_waitcnt vmcnt(0)" ::: "memory"); SWRITE(0, SE); __syncthreads();
  qkt(pA0, pA1, K_lds, KP_lds, QP_lds, qr, r32, hi); partialSM(pA0, pA1, m_reg, mnA, alA);
  SLOAD(SO, KVBLK); if constexpr (SDEPTH == 2) { if (2 < NT) SLOAD(SE, 2 * KVBLK); }
  SWAIT(); SWRITE(1, SO); __syncthreads();
  for (int j = 1; j + 1 < NT; j += 2) {
    SBAR(); qkt(pB0, pB1, K_lds + SHM_K, KP_lds + SHM_KP, QP_lds, qr, r32, hi);
    finishSM(pA0, pA1, alA, l_reg, pa0, pa1, pa2, pa3); SBAR();
    SLOAD(SO, (j + SDEPTH) * KVBLK); SBAR();
    pv_d0(o, vb0, pa0, pa1, pa2, pa3); partialSM(pB0, pB1, m_reg, mnB, alB);
    __syncthreads(); SWAIT(); SWRITE(0, SE);
    RESC(alB); __syncthreads();
    SBAR(); qkt(pA0, pA1, K_lds, KP_lds, QP_lds, qr, r32, hi);
    finishSM(pB0, pB1, alB, l_reg, pa0, pa1, pa2, pa3); SBAR();
    if (SDEPTH == 1 || j + 3 < NT) SLOAD(SE, (j + 1 + SDEPTH) * KVBLK); SBAR();
    pv_d0(o, vb0 + SHM_V, pa0, pa1, pa2, pa3); partialSM(pA0, pA1, m_reg, mnA, alA);
    __syncthreads(); SWAIT(); SWRITE(1, SO);
    RESC(alA); __syncthreads();
  }
  SBAR(); qkt(pB0, pB1, K_lds + SHM_K, KP_lds + SHM_KP, QP_lds, qr, r32, hi);
  finishSM(pA0, pA1, alA, l_reg, pa0, pa1, pa2, pa3); SBAR();
  pv_d0(o, vb0, pa0, pa1, pa2, pa3); partialSM(pB0, pB1, m_reg, mnB, alB);
  __syncthreads(); RESC(alB);
  finishSM(pB0, pB1, alB, l_reg, pa0, pa1, pa2, pa3); SBAR();
  pv_d0(o, vb0 + SHM_V, pa0, pa1, pa2, pa3);
  if (hi == 0) li_l[r32] = l_reg; asm volatile("s_waitcnt lgkmcnt(0)" ::: "memory");
  float rli[16];
#pragma unroll
  for (int r = 0; r < 16; ++r) rli[r] = __builtin_amdgcn_rcpf(li_l[crow(r, hi)]);
  bf16_t* Ow = Ob + (long)(wid * QBLK) * LDO;
#pragma unroll
  for (int r = 0; r < 16; ++r) { int orow = crow(r, hi);
#pragma unroll
    for (int d0 = 0; d0 < 4; ++d0) Ow[(long)orow * LDO + d0 * 32 + r32] = (bf16_t)(cvt_pk(o[d0][r] * rli[r], 0.f) & 0xffffu); }
  __syncthreads();
#undef SLOAD
#undef SWRITE
#undef SWAIT
#undef RESC
}
#undef SBAR
}

struct Ctx { int tid, lane, wave, G, bx, vcu; char* lds; };

__device__ __forceinline__ void phase_mods(const Params& p, const Ctx& c_in) {
  Ctx c = c_in; c.tid = opaque(c_in.tid); c.lane = c.tid & 63; c.wave = __builtin_amdgcn_readfirstlane(c.tid >> 6);
  float* sl = (float*)c.lds;
  float* red = sl + 5 * 2048;
  for (int i = c.tid; i < 5 * 2048; i += 512) { const int r = i >> 11, k = i & 2047; const float v = r < 4 ? p.c[r * 2048 + k] : p.c_ctx[k]; sl[i] = v * fsigmoid(v); }
  __syncthreads();
  float* mods = (float*)(p.ws + WS_MODS);
  for (int ch = c.bx; ch < 256; ch += c.G) {
    const int l = ch >> 7, n0 = (ch & 127) * 96;
    const int cgp = c.tid % 24, ks = c.tid / 24;
    float a[5][4];
#pragma unroll
    for (int r = 0; r < 5; ++r)
#pragma unroll
      for (int j = 0; j < 4; ++j) a[r][j] = 0.f;
    if (c.tid < 384) {
      const float* W = p.ada_w + (size_t)l * 2048 * 12288 + n0 + 4 * cgp;
      for (int k = ks; k < 2048; k += 16) { const f32x4 w = *(const f32x4*)(W + (size_t)k * 12288);
#pragma unroll
        for (int r = 0; r < 5; ++r) { const float s = sl[r * 2048 + k];
#pragma unroll
          for (int j = 0; j < 4; ++j) a[r][j] += s * w[j]; } }
#pragma unroll
      for (int r = 0; r < 5; ++r)
#pragma unroll
        for (int j = 0; j < 4; ++j) red[(ks * 24 + cgp) * 20 + r * 4 + j] = a[r][j];
    }
    __syncthreads();
    if (c.tid < 480) { const int r = c.tid / 96, n = c.tid % 96, cg2 = n >> 2, j = n & 3; float s = 0.f;
      for (int q = 0; q < 16; ++q) s += red[(q * 24 + cg2) * 20 + r * 4 + j];
      mods[((size_t)l * 5 + r) * 12288 + n0 + n] = s + p.ada_b[l * 12288 + n0 + n]; }
    __syncthreads();
  }
}
__device__ __forceinline__ void phase_tables(const Params& p, const Ctx& c_in) {
  Ctx c = c_in; c.tid = opaque(c_in.tid); c.lane = c.tid & 63; c.wave = __builtin_amdgcn_readfirstlane(c.tid >> 6);
  float* T = (float*)c.lds;
  for (int i = c.tid; i < 4096; i += 512) T[i] = cosf((float)i * (6.283185307179586f / 4096.f)) * (1.f / 64.f);
  __syncthreads();
  const long gt = (long)c.bx * 512 + c.tid, GT = (long)c.G * 512;
  float* rc = (float*)(p.ws + WS_ROPEC); float* rs = (float*)(p.ws + WS_ROPES);
  for (long i = gt; i < 4096 * 32; i += GT) { const int pos = (int)(i >> 5), f = (int)(i & 31);
    const float inv = powf(10000.f, -(float)(f & 15) / 16.f); const float ang = (float)(f < 16 ? (pos >> 6) : (pos & 63)) * inv;
    rc[i] = cosf(ang); rs[i] = sinf(ang); }
  { bf16_t* fa = (bf16_t*)(p.ws + WS_FFTA); bf16_t* fc = (bf16_t*)(p.ws + WS_FFTC); float* twc = (float*)(p.ws + WS_TWC); float* tws = (float*)(p.ws + WS_TWS);
    for (long i = gt; i < 256 * 128; i += GT) { const int rho = (int)(i >> 7), kap = (int)(i & 127), cc = kap >> 6, nn = kap & 63;
      float va = 0.f, vc = 0.f;
      if (rho < 128) { const int wr_ = rho >> 6, m_ = (rho >> 4) & 3, fr_ = rho & 15, k1 = 32 * wr_ + 16 * (m_ & 1) + fr_, isim = m_ >> 1, r = (k1 * nn) & 63;
        const float cs_ = T[(64 * r) & 4095] * 8.f, sn_ = T[(64 * r + 3072) & 4095] * 8.f;
        va = isim ? (cc ? -cs_ : -sn_) : (cc ? -sn_ : cs_); }
      if (rho < 64) { const int r = (rho * nn) & 63; vc = cc ? T[(64 * r + 3072) & 4095] * 8.f : T[(64 * r) & 4095] * 8.f; }
      fa[i] = (bf16_t)(cvt_pk(va, 0.f) & 0xffffu); fc[i] = (bf16_t)(cvt_pk(vc, 0.f) & 0xffffu); }
    for (long i = gt; i < 64 * 64; i += GT) { const int k1 = (int)(i >> 6), n2 = (int)(i & 63), r = k1 * n2; twc[i] = T[r & 4095] * 64.f; tws[i] = T[(r + 3072) & 4095] * 64.f; } }
  bf16_t* dc = (bf16_t*)(p.ws + WS_DFTC);
  for (long i = gt; i < 256 * 512; i += GT) { const int m = (int)(i >> 9), kk = (int)(i & 511), n = kk & 255, s = kk >> 8;
    dc[i] = (bf16_t)(cvt_pk(T[(((m * n + 64 * s) & 255) * 16) & 4095] * 4.f, 0.f) & 0xffffu); }
  bf16_t* cs = (bf16_t*)(p.ws + WS_CS1);
  for (long i = gt; i < 256 * 128; i += GT) { const int jp = (int)(i >> 7), j = (int)(i & 127), l = jp & 127, s = jp >> 7;
    cs[i] = (bf16_t)(cvt_pk(T[(((l * j) & 127) * 32 + 3072 * s) & 4095] * 5.656854249492381f, 0.f) & 0xffffu); }
  __syncthreads();
}

enum { J_IN = 0, J_F, J_C, J_UQ, J_UKV, J_MLA, J_OUT, J_GU, J_DN, J_NUM };
struct WJob { const float* src; const float* src2; const float* gain; bf16_t* dst; int K, Nd, ldn, kind; };
__device__ __forceinline__ const float* wsrc(const WJob& j, int n0) {
  const int tile = n0 >> 8, r = n0 & 255;
  switch (j.kind) {
    case J_IN:
      if (tile < 4) return j.src + n0;
      if (tile < 12) { const int t = tile - 4; return j.src + (r < 128 ? F_END + 128 * t + r : F_END + 1024 + 128 * t + (r - 128)); }
      if (tile < 15) return j.src + C_END + (n0 - 12 * 256);
      if (tile < 17) return j.src + Q_END + (n0 - 15 * 256);
      if (tile == 17) return r == 0 ? j.src + KV_END : (r == 128 ? j.src + KV_END + 32 : nullptr);
      return j.src + KPE_END + (n0 - 18 * 256);
    case J_UQ:
      if (tile < 8) return j.src + (n0 >> 7) * 192 + (n0 & 127);
      { const int t = tile - 8, bj = r >> 7, wc = (r >> 5) & 3; return j.src + (4 * t + wc) * 192 + 128 + bj * 32; }
    case J_UKV:
      if (tile < 8) return j.src + (n0 >> 7) * 256 + (n0 & 127);
      { const int n1 = n0 - 2048; return j.src + (n1 >> 7) * 256 + 128 + (n1 & 127); }
    case J_GU:
      return (r < 128 ? j.src : j.src2) + 128 * tile + (r & 127);
    default: return j.src + n0;
  }
}
__device__ __forceinline__ void transpose_item(const WJob& j, int item, LAS float* scr, int lane) {
  const int nblk = j.Nd / 64, kb = item / nblk, nb = item % nblk, k0 = 64 * kb, n0 = 64 * nb;
  const int col4 = (lane & 15) * 4;
  const float* s = wsrc(j, n0 + (col4 & 32));
  f32x4 v[16];
#pragma unroll
  for (int i = 0; i < 16; ++i) { const int kk = 4 * i + (lane >> 4); v[i] = (f32x4){0.f, 0.f, 0.f, 0.f};
    if (s) { v[i] = *(const f32x4*)(s + (size_t)(k0 + kk) * j.ldn + (col4 & 31)); if (j.gain) v[i] = v[i] * j.gain[k0 + kk]; } }
#pragma unroll
  for (int i = 0; i < 16; ++i) { const int kk = 4 * i + (lane >> 4);
#pragma unroll
    for (int e = 0; e < 4; ++e) scr[kk * 65 + col4 + e] = v[i][e]; }
  asm volatile("s_waitcnt lgkmcnt(0)" ::: "memory");
  const int cch = lane & 7;
#pragma unroll
  for (int q = 0; q < 8; ++q) { const int n = (lane >> 3) + 8 * q; const LAS float* t = scr + (8 * cch) * 65 + n;
    u32x4 o; o.x = cvt_pk(t[0 * 65], t[1 * 65]); o.y = cvt_pk(t[2 * 65], t[3 * 65]); o.z = cvt_pk(t[4 * 65], t[5 * 65]); o.w = cvt_pk(t[6 * 65], t[7 * 65]);
    *(u32x4*)(j.dst + (size_t)(n0 + n) * j.K + k0 + 8 * cch) = o; }
  asm volatile("s_waitcnt lgkmcnt(0)" ::: "memory");
}
__device__ __forceinline__ void phase_wconv(const Params& p, const Ctx& c_in, int l) {
  Ctx c = c_in; c.tid = opaque(c_in.tid); c.lane = c.tid & 63; c.wave = __builtin_amdgcn_readfirstlane(c.tid >> 6);
  LAS float* scr = (LAS float*)((LAS unsigned char*)c.lds + c.wave * 16640);
  const int gw = c.vcu * 8 + c.wave, NGW = c.G * 8;
  unsigned char* ws = p.ws;
#pragma unroll 1
  for (int jk = 0; jk < J_NUM; ++jk) {
    WJob j; j.src2 = nullptr; j.gain = nullptr; j.kind = jk;
    switch (jk) {
      case J_IN: j.src = p.w_in + (size_t)l * 2048 * IN_COLS; j.dst = (bf16_t*)(ws + WS_WIN); j.K = 2048; j.Nd = 10752; j.ldn = IN_COLS; break;
      case J_F: j.src = p.w_fourier + (size_t)l * 1024 * 2048; j.dst = (bf16_t*)(ws + WS_WF); j.K = 1024; j.Nd = 2048; j.ldn = 2048; break;
      case J_C: j.src = p.w_conv_out + (size_t)l * 1024 * 2048; j.dst = (bf16_t*)(ws + WS_WC); j.K = 1024; j.Nd = 2048; j.ldn = 2048; break;
      case J_UQ: j.src = p.w_uq + (size_t)l * 768 * 3072; j.gain = p.q_norm_g + l * 768; j.dst = (bf16_t*)(ws + WS_WUQ); j.K = 768; j.Nd = 3072; j.ldn = 3072; break;
      case J_UKV: j.src = p.w_ukv + (size_t)l * 512 * 4096; j.gain = p.kv_norm_g + l * 512; j.dst = (bf16_t*)(ws + WS_WUKV); j.K = 512; j.Nd = 4096; j.ldn = 4096; break;
      case J_MLA: j.src = p.w_mla_o + (size_t)l * 2048 * 2048; j.dst = (bf16_t*)(ws + WS_WMLA); j.K = 2048; j.Nd = 2048; j.ldn = 2048; break;
      case J_OUT: j.src = p.w_out + (size_t)l * 2048 * 2048; j.dst = (bf16_t*)(ws + WS_WOUT); j.K = 2048; j.Nd = 2048; j.ldn = 2048; break;
      case J_GU: j.src = p.w_ffn_gate + (size_t)l * 2048 * FFH; j.src2 = p.w_ffn_up + (size_t)l * 2048 * FFH; j.dst = (bf16_t*)(ws + WS_WGU); j.K = 2048; j.Nd = 2 * FFH; j.ldn = FFH; break;
      default: j.src = p.w_ffn_down + (size_t)l * FFH * 2048; j.dst = (bf16_t*)(ws + WS_WDN); j.K = FFH; j.Nd = 2048; j.ldn = 2048; break;
    }
    const int nitems = (j.K / 64) * (j.Nd / 64);
    for (int it = gw; it < nitems; it += NGW) transpose_item(j, it, scr, c.lane);
  }
}
__device__ __forceinline__ void phase_normmod(const Params& p, const Ctx& c_in, const float* xl, const float* xc, const float* gain, const float* mods_l, int sh_idx, int nrows, bf16_t* hout,
                                              const float* part, const float* pgate, float* xstore) {
  Ctx c = c_in; c.tid = opaque(c_in.tid); c.lane = c.tid & 63; c.wave = __builtin_amdgcn_readfirstlane(c.tid >> 6);
  const int gw = c.vcu * 8 + c.wave, NGW = c.G * 8;
  for (int row = gw; row < nrows; row += NGW) {
    const float* xr = row < MX ? xl + (size_t)row * 2048 : xc + (size_t)(row - MX) * 2048;
    const float* md = mods_l + modgrp(row) * 12288;
    f32x4 v[8]; float ss = 0.f;
#pragma unroll
    for (int q = 0; q < 8; ++q) { const int col = q * 256 + c.lane * 4; v[q] = *(const f32x4*)(xr + col);
      if (part && row >= MX) { const float* pr = part + (size_t)(row - MX) * 2048 + col; const size_t ps = (size_t)1024 * 2048;
        const f32x4 sum = (*(const f32x4*)pr + *(const f32x4*)(pr + ps)) + (*(const f32x4*)(pr + 2 * ps) + *(const f32x4*)(pr + 3 * ps));
        v[q] = v[q] + *(const f32x4*)(pgate + col) * sum; if (xstore) *(f32x4*)(xstore + (size_t)(row - MX) * 2048 + col) = v[q]; }
      ss += (v[q][0] * v[q][0] + v[q][1] * v[q][1]) + (v[q][2] * v[q][2] + v[q][3] * v[q][3]); }
    const float rstd = 1.0f / sqrtf(wave_sum(ss) * (1.f / 2048.f) + EPS);
#pragma unroll
    for (int q = 0; q < 8; ++q) { const int col = q * 256 + c.lane * 4; const f32x4 g = *(const f32x4*)(gain + col), sh = *(const f32x4*)(md + sh_idx * 2048 + col), sc = *(const f32x4*)(md + (sh_idx + 1) * 2048 + col);
      const f32x4 y = v[q] * rstd * g * (sc + 1.f) + sh; u32x2 w; w.x = cvt_pk(y[0], y[1]); w.y = cvt_pk(y[2], y[3]);
      *(u32x2*)(hout + (size_t)row * 2048 + col) = w; }
  }
}
__device__ __forceinline__ void phase_conv(const Params& p, const Ctx& c_in, int l, int nrows, int cidx) {
  Ctx c = c_in; c.tid = opaque(c_in.tid); c.lane = c.tid & 63; c.wave = __builtin_amdgcn_readfirstlane(c.tid >> 6);
  constexpr int TT = 16, HALO = 15, NR = TT + 2 * HALO;
  const bf16_t* vb = (const bf16_t*)(p.ws + WS_VB); bf16_t* ob = (bf16_t*)(p.ws + WS_CBF);
  unsigned* tile = (unsigned*)c.lds;
  f32x2* red = (f32x2*)(c.lds + NR * 2048);
  const int ch = 2 * c.tid;
  float w0[31], w1[31];
#pragma unroll
  for (int k = 0; k < 31; ++k) { const f32x2 w = *(const f32x2*)(p.conv_w + ((size_t)l * 31 + k) * 1024 + ch); w0[k] = w[0]; w1[k] = w[1]; }
  const f32x2 cb = *(const f32x2*)(p.conv_b + l * 1024 + ch), lg = *(const f32x2*)(p.conv_ln_g + l * 1024 + ch), lb = *(const f32x2*)(p.conv_ln_b + l * 1024 + ch);
  const int ntiles = nrows / TT;
  for (int t = cidx; t < ntiles; t += c.G) {
    const int r0 = t * TT; const int seqlen = r0 < MX ? SEQ : CTXL; const int sbeg = r0 < MX ? (r0 & ~(SEQ - 1)) : MX + ((r0 - MX) & ~(CTXL - 1)); const int send = sbeg + seqlen;
    for (int i = c.tid; i < NR * 128; i += 512) { const int rr = i >> 7, cc = i & 127, row = r0 - HALO + rr; u32x4 v = {0u, 0u, 0u, 0u};
      if (row >= sbeg && row < send) v = *(const u32x4*)(vb + (size_t)row * 1024 + cc * 8);
      *(u32x4*)(tile + rr * 512 + cc * 4) = v; }
    __syncthreads();
    float y0[TT], y1[TT];
#pragma unroll
    for (int tt = 0; tt < TT; ++tt) { float a0 = cb[0], a1 = cb[1];
#pragma unroll
      for (int k = 0; k < 31; ++k) { const unsigned w = tile[(tt + k) * 512 + c.tid]; a0 += bflo(w) * w0[k]; a1 += bfhi(w) * w1[k]; }
      y0[tt] = a0; y1[tt] = a1;
      const float s = wave_sum(a0 + a1), q = wave_sum(a0 * a0 + a1 * a1);
      if (c.lane == 0) red[tt * 8 + c.wave] = (f32x2){s, q}; }
    __syncthreads();
#pragma unroll
    for (int tt = 0; tt < TT; ++tt) { float s = 0.f, q = 0.f;
#pragma unroll
      for (int w = 0; w < 8; ++w) { const f32x2 r = red[tt * 8 + w]; s += r[0]; q += r[1]; }
      const float mu = s * (1.f / 1024.f); const float var = fmaxf(q * (1.f / 1024.f) - mu * mu, 0.f); const float rstd = 1.0f / sqrtf(var + EPS);
      float z0 = (y0[tt] - mu) * rstd * lg[0] + lb[0], z1 = (y1[tt] - mu) * rstd * lg[1] + lb[1];
      z0 = z0 * fsigmoid(z0); z1 = z1 * fsigmoid(z1);
      *(unsigned*)(ob + (size_t)(r0 + tt) * 1024 + ch) = cvt_pk(z0, z1); }
    __syncthreads();
  }
}
__device__ __forceinline__ void phase_final(const Params& p, const Ctx& c_in) {
  Ctx c = c_in; c.tid = opaque(c_in.tid); c.lane = c.tid & 63; c.wave = __builtin_amdgcn_readfirstlane(c.tid >> 6);
  const int gw = c.vcu * 8 + c.wave, NGW = c.G * 8;
  for (int row = gw; row < MX; row += NGW) { float* xr = p.out + (size_t)row * 2048; f32x4 v[8]; float ss = 0.f;
#pragma unroll
    for (int q = 0; q < 8; ++q) { v[q] = *(const f32x4*)(xr + q * 256 + c.lane * 4); ss += (v[q][0] * v[q][0] + v[q][1] * v[q][1]) + (v[q][2] * v[q][2] + v[q][3] * v[q][3]); }
    const float rstd = 1.0f / sqrtf(wave_sum(ss) * (1.f / 2048.f) + EPS);
#pragma unroll
    for (int q = 0; q < 8; ++q) { const int col = q * 256 + c.lane * 4; *(f32x4*)(xr + col) = v[q] * rstd * *(const f32x4*)(p.final_norm_g + col); } }
}

constexpr int LDS_BYTES = 147456;
__device__ __forceinline__ void grid_barrier(unsigned char* ws, volatile LAS unsigned* nbar_lds) {
  asm volatile("s_waitcnt vmcnt(0) lgkmcnt(0)" ::: "memory");
  __syncthreads();
  if (threadIdx.x == 0) {
    unsigned* bar = (unsigned*)(ws + WS_FLAGS); const unsigned G = gridDim.x, nbar = *nbar_lds;
    __builtin_amdgcn_fence(__ATOMIC_RELEASE, "agent"); asm volatile("s_waitcnt vmcnt(0)" ::: "memory");
    const unsigned old = __hip_atomic_fetch_add(bar, 1u, __ATOMIC_RELAXED, __HIP_MEMORY_SCOPE_AGENT);
    if (old + 1u == G * (nbar + 1u)) __hip_atomic_store(bar + 64, nbar + 1u, __ATOMIC_RELAXED, __HIP_MEMORY_SCOPE_AGENT);
    else while (__hip_atomic_load(bar + 64, __ATOMIC_RELAXED, __HIP_MEMORY_SCOPE_AGENT) <= nbar) __builtin_amdgcn_s_sleep(2);
    __builtin_amdgcn_fence(__ATOMIC_ACQUIRE, "agent"); asm volatile("s_waitcnt vmcnt(0)" ::: "memory");
    *nbar_lds = nbar + 1u;
  }
  __syncthreads();
}
enum { SK_NONE = 0, SK_GEMM, SK_P0, SK_CONV, SK_ATT, SK_NORM2, SK_CMERGE };
constexpr int NSTEP = 31;
__device__ __forceinline__ Params load_params() { KArgP ka = kargs(); Params P; __builtin_memcpy(&P, (const void*)ka, sizeof(Params)); return P; }
__global__ void __launch_bounds__(512, 2) mk_fwd(Params p_unused) {
  extern __shared__ __attribute__((aligned(16))) unsigned char lds_raw[];
  cg::grid_group grid = cg::this_grid();
  Ctx c; c.tid = threadIdx.x; c.lane = c.tid & 63; c.wave = __builtin_amdgcn_readfirstlane(c.tid >> 6); c.G = gridDim.x; c.bx = blockIdx.x;
  c.vcu = (c.G % 8 == 0) ? (c.bx % 8) * (c.G / 8) + c.bx / 8 : c.bx; c.lds = (char*)lds_raw;
  LAS unsigned char* lds3 = (LAS unsigned char*)lds_raw;
  unsigned char* ws = kargs()->ws;
  const int G = c.G;

  volatile LAS unsigned* nbar_lds = (volatile LAS unsigned*)(lds3 + LDS_BYTES - 64);
  if (c.tid == 0) *nbar_lds = 0u;
  grid.sync();
  { const Params P = load_params(); phase_mods(P, c); phase_tables(P, c); }
  grid_barrier(ws, nbar_lds);

#pragma unroll 1
  for (int l = 0; l < 2; ++l) {
    const int nM = l == 0 ? 68 : 64;
    int base = 0;
#pragma unroll 1
    for (int st = 0; st < NSTEP; ++st) {
      int kind = SK_GEMM, sync = 0, K = 2048, oM = nM, oN = 8, rot = 0;
      size_t aofs = WS_H, bofs = WS_WIN;
      pg8::Epi E{}; E.l = l; E.ws = ws; pg8::Geo g{}; g.mode = pg8::GEO_STD; g.lda = 2048; g.ldb = 2048;
      const int sx = st < 8 ? st : (st == 8 ? 100 : st - 1);
      switch (sx) {
        case 0: kind = SK_P0; sync = 1; break;
        case 1:
          E.mode = pg8::E_IN; oN = 18; sync = (l == 0); break;
        case 2:
          if (l == 0) { kind = SK_NONE; break; }
          E.mode = pg8::E_IN; E.pm_off = 64; E.pn_off = 15; aofs = WS_H + (size_t)MX * 2048 * 2; bofs = WS_WIN + (size_t)15 * 256 * 2048 * 2; oM = 4; oN = 3; rot = 64 * 18; sync = 1; break;
        case 3:
          E.mode = pg8::E_DFT1; g.mode = pg8::GEO_DFT1; g.lda = 128; g.ldb = 1024; aofs = WS_CS1; bofs = WS_UF; K = 128; oM = 1; oN = 512; base = 0; break;
        case 4:
          if (l != 0) { kind = SK_NONE; break; }
          E.mode = pg8::E_DFT1; E.aux = 1; g.mode = pg8::GEO_DFT1; g.aux = 1; g.lda = 128; g.ldb = 1024; aofs = WS_CS1; bofs = WS_UF + (size_t)MX * 1024 * 2; K = 128; oM = 1; oN = 32; rot = base; break;
        case 5:
          E.mode = pg8::E_UQ; g.lda = 768; g.ldb = 768; aofs = WS_QD; bofs = WS_WUQ; K = 768; oN = 12; rot = base; break;
        case 6:
          E.mode = pg8::E_UKV; g.lda = 512; g.ldb = 512; aofs = WS_KVD; bofs = WS_WUKV; K = 512; oM = 68; oN = 16; rot = base; break;
        case 7: kind = SK_CONV; rot = base; sync = 1; break;
        case 8: kind = SK_ATT; break;
        case 100:
          E.mode = pg8::E_FFTA; g.mode = pg8::GEO_A0; g.lda = 128; g.ldb = 128; aofs = WS_FFTA; bofs = WS_ZT; K = 128; oM = 1; oN = 1024; sync = 1; break;
        case 9:
          E.mode = pg8::E_FFTC; g.mode = pg8::GEO_A0; g.lda = 128; g.ldb = 128; aofs = WS_FFTC; bofs = WS_GP; K = 128; oM = 1; oN = 1024; sync = (l != 0); break;
        case 10:
          if (l != 0) { kind = SK_NONE; break; }
          E.mode = pg8::E_DFT2; E.aux = 1; g.mode = pg8::GEO_DFT2; g.aux = 1; g.lda = 512; g.ldb = 512; aofs = WS_DFTC; bofs = WS_ZTC; K = 512; oM = 1; oN = 16; rot = G - 64; sync = 1; break;
        case 11: case 13: case 15: {
          const int br = (sx - 11) >> 1; E.mode = pg8::E_GATE; E.aux = br; oM = 64; bofs = WS_WIN + (size_t)(18 * 256 + br * 2048) * 2048 * 2; break; }
        case 12: case 14: case 16: {
          const int br = (sx - 12) >> 1; E.mode = pg8::E_Y; E.aux = (br == 0); oM = 64;
          K = br == 2 ? 2048 : 1024; g.lda = K; g.ldb = K;
          aofs = br == 0 ? WS_F : (br == 1 ? WS_CBF : WS_O); bofs = br == 0 ? WS_WF : (br == 1 ? WS_WC : WS_WMLA);
          sync = (br == 2 && l != 0); break; }
        case 17: case 18: case 19: {
          if (l != 0) { kind = SK_NONE; break; }
          const int br = sx - 17; E.mode = pg8::E_GATE; E.aux = 4 + br; E.pm_off = 64; oM = 4; rot = 32 * (sx - 17);
          aofs = WS_H + (size_t)MX * 2048 * 2; bofs = WS_WIN + (size_t)(18 * 256 + br * 2048) * 2048 * 2; break; }
        case 20: case 21: case 22: {
          if (l != 0) { kind = SK_NONE; break; }
          const int br = sx - 20; E.mode = pg8::E_YC; E.aux = br; E.pm_off = 64; oM = 4; rot = 32 * (sx - 17);
          K = br == 2 ? 2048 : 1024; g.lda = K; g.ldb = K;
          aofs = (br == 0 ? WS_F : (br == 1 ? WS_CBF : WS_O)) + (size_t)MX * K * 2; bofs = br == 0 ? WS_WF : (br == 1 ? WS_WC : WS_WMLA);
          sync = (br == 2); break; }
        case 23: if (l != 0) { kind = SK_NONE; break; } kind = SK_CMERGE; sync = 1; break;
        case 24:
          E.mode = pg8::E_RES; E.aux = 0; oM = 64; aofs = WS_MERGED; bofs = WS_WOUT; sync = (l != 0); break;
        case 25:
          if (l != 0) { kind = SK_NONE; break; }
          E.mode = pg8::E_RES; E.aux = 8; E.pm_off = 64; g.mode = pg8::GEO_SPLITK; g.aux = 512; K = 512; oM = 4; oN = 32;
          aofs = WS_MERGED + (size_t)MX * 2048 * 2; bofs = WS_WOUT; sync = 1; break;
        case 26: kind = SK_NORM2; sync = 1; break;
        case 27:
          E.mode = pg8::E_UP; bofs = WS_WGU; oN = 44; sync = 1; break;
        case 28:
          E.mode = pg8::E_RES; E.aux = 1; oM = 64; g.lda = FFH; g.ldb = FFH; aofs = WS_HID; bofs = WS_WDN; K = FFH; sync = (l != 0); break;
        default:
          if (l != 0) { kind = SK_NONE; break; }
          E.mode = pg8::E_RES; E.aux = 9; E.pm_off = 64; g.mode = pg8::GEO_SPLITK; g.aux = 1408; g.lda = FFH; g.ldb = FFH; K = 1408; oM = 4; oN = 32;
          aofs = WS_HID + (size_t)MX * FFH * 2; bofs = WS_WDN; sync = 1; break;
      }
      if (kind == SK_GEMM) {
        pg8::Order S; S.init(oM, oN, G, (c.bx + G - rot % G) % G);
#ifndef NO_GEMM
        pg8::gemm_phase(lds3, (const bf16_t*)(ws + aofs), (const bf16_t*)(ws + bofs), K, S, g, E);
#endif
        base += oM * oN;
      } else if (kind == SK_P0) {
        const Params P = load_params();
        const float* mods_l = (const float*)(ws + WS_MODS) + (size_t)l * 5 * 12288;
        phase_wconv(P, c, l);
        phase_normmod(P, c, l == 0 ? P.x : P.out, l == 0 ? P.ctx : (const float*)(ws + WS_CTXX), P.norm_mix_g + l * 2048, mods_l, 0, MT, (bf16_t*)(ws + WS_H),
                      l == 0 ? nullptr : (const float*)(ws + WS_PART), (const float*)(ws + WS_MODS) + 4 * 12288 + 5 * 2048, nullptr);
        float* ssq_q = (float*)(ws + WS_SSQQ); float* ssq_kv = (float*)(ws + WS_SSQKV);
        for (int i = c.bx * 512 + opaque(c.tid); i < MT; i += G * 512) { ssq_q[i] = 0.f; ssq_kv[i] = 0.f; }
      } else if (kind == SK_CONV) {
        __syncthreads();
        const Params P = load_params();
#ifndef NO_CONV
        phase_conv(P, c, l, nM * 256, (c.bx + G - rot % G) % G);
#endif
      } else if (kind == SK_ATT) {
        const bf16_t* Qp = (const bf16_t*)(ws + WS_Q); const bf16_t* Kp = (const bf16_t*)(ws + WS_KN); const bf16_t* KPp = (const bf16_t*)(ws + WS_KPE); const bf16_t* Vp = (const bf16_t*)(ws + WS_V);
        bf16_t* Op = (bf16_t*)(ws + WS_O);
#ifndef NO_ATT
#pragma unroll 1
        for (int u = c.vcu; u < 1024 + (l == 0 ? 64 : 0); u += G) {
          int b, h, qrow, krow0, seq;
          if (u < 1024) { const int bh = u >> 4, qb = u & 15; b = bh >> 4; h = bh & 15; qrow = b * SEQ + qb * 256; krow0 = b * KVS; seq = KVS; }
          else { const int uc = u - 1024; b = uc >> 4; h = uc & 15; qrow = MX + b * CTXL; krow0 = b * KVS + SEQ; seq = CTXL; }
          att::attn_body(Qp + (size_t)qrow * 3072 + h * 192, Kp + (size_t)krow0 * 2048 + h * 128, KPp + (size_t)krow0 * 64, Vp + (size_t)krow0 * 2048 + h * 128,
                         Op + (size_t)qrow * 2048 + h * 128, seq, c.lds);
        }
#endif
        __syncthreads();
      } else if (kind == SK_CMERGE) {
        const u32x4* gc = (const u32x4*)(ws + WS_GATEC); const u32x4* yc = (const u32x4*)(ws + WS_YC); u32x4* mo = (u32x4*)((bf16_t*)(ws + WS_MERGED) + (size_t)MX * 2048);
        const int n8 = 1024 * 2048 / 8;
        for (int i = c.bx * 512 + opaque(c.tid); i < n8; i += G * 512) { f32x4 a0 = {0.f, 0.f, 0.f, 0.f}, a1 = a0;
#pragma unroll
          for (int b = 0; b < 3; ++b) { const u32x4 gw = gc[i + b * n8], yw = yc[i + b * n8];
            a0[0] += bflo(gw.x) * bflo(yw.x); a0[1] += bfhi(gw.x) * bfhi(yw.x); a0[2] += bflo(gw.y) * bflo(yw.y); a0[3] += bfhi(gw.y) * bfhi(yw.y);
            a1[0] += bflo(gw.z) * bflo(yw.z); a1[1] += bfhi(gw.z) * bfhi(yw.z); a1[2] += bflo(gw.w) * bflo(yw.w); a1[3] += bfhi(gw.w) * bfhi(yw.w); }
          mo[i] = pack8(a0, a1); }
      } else if (kind == SK_NORM2) {
        const Params P = load_params();
        const float* mods_l = (const float*)(ws + WS_MODS) + (size_t)l * 5 * 12288;
        phase_normmod(P, c, P.out, l == 0 ? P.ctx : (const float*)(ws + WS_CTXX), P.norm_ffn_g + l * 2048, mods_l, 3, nM * 256, (bf16_t*)(ws + WS_H),
                      l == 0 ? (const float*)(ws + WS_PART) : nullptr, mods_l + 4 * 12288 + 2 * 2048, l == 0 ? (float*)(ws + WS_CTXX) : nullptr);
      }
      if (sync) grid_barrier(ws, nbar_lds);
    }
  }
#ifdef CUT
  grid_barrier(ws, nbar_lds);
  { const Params P = load_params(); const long N = (long)MX * DM; const bf16_t* wb = (const bf16_t*)(ws + WS_H); const long NB16 = (long)(WS_END - WS_H) / 2;
    const float* misc = (const float*)ws;
    for (long i = (long)c.bx * 512 + c.tid; i < N; i += (long)G * 512) { float a = P.out[i];
      for (long e = i; e < NB16; e += N) a += __uint_as_float(((unsigned)wb[e]) << 16);
      if (i < (long)(3 * MiB)) a += misc[i];
      P.out[i] = a; } }
#else
  { const Params P = load_params(); phase_final(P, c); }
#endif
}

extern "C" void kernel_launch(void* const* d_in, const int* in_sizes, int n_in, void* d_out, int out_size, void* d_ws, size_t ws_size, hipStream_t stream) {
  static int grid_blocks = 0;
  if (!grid_blocks) {
    if (n_in != 26 || out_size != MX * DM || ws_size < WS_END) { fprintf(stderr, "kernel_launch: unexpected shapes / workspace (%d inputs, out %d, ws %zu < %zu)\n", n_in, out_size, ws_size, (size_t)WS_END); grid_blocks = -1; return; }
    int dev = 0, cus = 0, per_cu = 0;
    (void)hipGetDevice(&dev);
    (void)hipDeviceGetAttribute(&cus, hipDeviceAttributeMultiprocessorCount, dev);
    if (hipFuncSetAttribute((const void*)mk_fwd, hipFuncAttributeMaxDynamicSharedMemorySize, LDS_BYTES) != hipSuccess) { fprintf(stderr, "hipFuncSetAttribute failed\n"); grid_blocks = -1; return; }
    (void)hipOccupancyMaxActiveBlocksPerMultiprocessor(&per_cu, (const void*)mk_fwd, 512, LDS_BYTES);
    (void)hipGetLastError();
    grid_blocks = cus;
  }
  if (grid_blocks < 0) return;
  if (hipMemsetAsync(d_ws, 0, 1024, stream) != hipSuccess) { fprintf(stderr, "memset of barrier words failed\n"); return; }
  Params p{};
  const float** pp = (const float**)&p;
  for (int i = 0; i < 26; ++i) pp[i] = (const float*)d_in[i];
  p.out = (float*)d_out; p.ws = (unsigned char*)d_ws; p.ph_lo = 0; p.ph_hi = 1000;
  void* args[] = {&p};
  hipError_t e = hipLaunchCooperativeKernel((void*)mk_fwd, dim3(grid_blocks), dim3(512), args, LDS_BYTES, stream);
  if (e != hipSuccess) fprintf(stderr, "cooperative launch failed: %s (grid %d)\n", hipGetErrorString(e), grid_blocks);
}
```

```cpp
#include <hip/hip_runtime.h>
#include <hip/hip_cooperative_groups.h>
#include <cstdio>
#include <cstdint>
namespace cg = cooperative_groups;

#define LAS __attribute__((address_space(3)))
typedef unsigned short bf16_t;
typedef short bf16x8 __attribute__((ext_vector_type(8)));
typedef short s16x4 __attribute__((ext_vector_type(4)));
typedef float f32x4 __attribute__((ext_vector_type(4)));
typedef float f32x2 __attribute__((ext_vector_type(2)));
typedef float f32x16 __attribute__((ext_vector_type(16)));
typedef unsigned u32x4 __attribute__((ext_vector_type(4)));
typedef unsigned u32x2 __attribute__((ext_vector_type(2)));

constexpr int DM = 2048, NB = 4, SEQ = 4096, CTXL = 256;
constexpr int MX = NB * SEQ, MC = NB * CTXL, MT = MX + MC;
constexpr int KVS = SEQ + CTXL;
constexpr int F_END = 1024, C_END = 3072, Q_END = 3840, KV_END = 4352, KPE_END = 4416, IN_COLS = 10560;
constexpr int FFH = 5632;
constexpr float EPS = 1e-6f;

struct Params {
  const float *x, *c, *ctx, *c_ctx, *ada_w, *ada_b, *norm_mix_g, *w_in, *b_gate, *w_fourier, *conv_w, *conv_b, *conv_ln_g, *conv_ln_b,
      *w_conv_out, *q_norm_g, *w_uq, *kv_norm_g, *w_ukv, *w_mla_o, *w_out, *norm_ffn_g, *w_ffn_gate, *w_ffn_up, *w_ffn_down, *final_norm_g;
  float* out; unsigned char* ws; int ph_lo, ph_hi;
};

typedef const __attribute__((address_space(4))) Params* KArgP;
__device__ __forceinline__ KArgP kargs() { KArgP q = (KArgP)__builtin_amdgcn_kernarg_segment_ptr(); asm volatile("" : "+s"(q)); return q; }

constexpr size_t MiB = 1u << 20;
constexpr size_t WS_FLAGS = 0, WS_SSQQ = 64 * 1024, WS_SSQKV = 192 * 1024, WS_MODS = 512 * 1024, WS_ROPEC = 1 * MiB, WS_ROPES = 1 * MiB + 512 * 1024,
                 WS_CS1 = 2 * MiB, WS_DFTC = 2 * MiB + 256 * 1024,
                 WS_FFTA = 2 * MiB + 512 * 1024, WS_FFTC = WS_FFTA + 64 * 1024, WS_TWC = WS_FFTC + 64 * 1024, WS_TWS = WS_TWC + 16 * 1024;
constexpr size_t WS_CTXX = 4 * MiB, WS_GP = 12 * MiB;
constexpr size_t WS_WIN = 76 * MiB, WS_WF = 118 * MiB, WS_WC = 122 * MiB, WS_WUQ = 126 * MiB, WS_WUKV = 131 * MiB, WS_WMLA = 135 * MiB, WS_WOUT = 143 * MiB,
                 WS_WGU = 151 * MiB, WS_WDN = 195 * MiB;
constexpr size_t WS_H = 217 * MiB, WS_Q = 285 * MiB, WS_TMPG = 285 * MiB, WS_HID = 285 * MiB, WS_KN = 387 * MiB, WS_MERGED = 387 * MiB, WS_V = 455 * MiB,
                 WS_ZT = 523 * MiB, WS_ZTC = 587 * MiB, WS_CBF = 591 * MiB, WS_KPE = 625 * MiB, WS_UF = 628 * MiB, WS_O = 628 * MiB, WS_VB = 662 * MiB,
                 WS_QD = 696 * MiB, WS_F = 696 * MiB, WS_KVD = 722 * MiB, WS_GATEC = 739 * MiB, WS_YC = 751 * MiB, WS_PART = 763 * MiB, WS_END = 795 * MiB;

typedef __bf16 bf16x2_t __attribute__((ext_vector_type(2)));
__device__ __forceinline__ unsigned cvt_pk(float lo, float hi) { f32x2 v = {lo, hi}; bf16x2_t b = __builtin_convertvector(v, bf16x2_t); return __builtin_bit_cast(unsigned, b); }
__device__ __forceinline__ int opaque(int v) { asm volatile("" : "+v"(v)); return v; }
__device__ __forceinline__ float bflo(unsigned w) { return __uint_as_float(w << 16); }
__device__ __forceinline__ float bfhi(unsigned w) { return __uint_as_float(w & 0xffff0000u); }
__device__ __forceinline__ float fsigmoid(float x) { return __builtin_amdgcn_rcpf(1.f + __expf(-x)); }
__device__ __forceinline__ float wave_sum(float v) {
#pragma unroll
  for (int o = 1; o < 64; o <<= 1) v += __shfl_xor(v, o);
  return v;
}
__device__ __forceinline__ u32x4 pack8(f32x4 a, f32x4 b) { u32x4 w; w.x = cvt_pk(a[0], a[1]); w.y = cvt_pk(a[2], a[3]); w.z = cvt_pk(b[0], b[1]); w.w = cvt_pk(b[2], b[3]); return w; }
__device__ __forceinline__ int kvrow(int row) { return row < MX ? (row >> 12) * KVS + (row & 4095) : ((row - MX) >> 8) * KVS + SEQ + ((row - MX) & 255); }
__device__ __forceinline__ int modgrp(int row) { return row < MX ? (row >> 12) : 4; }

namespace pg8 {
constexpr int BM = 256, BK = 64, HALF = 128, HTB = HALF * BK * 2, STAGE_BYTES = 8 * HTB, NXCD = 8, WGM = 8;
__host__ __device__ __forceinline__ int lds_byte(int r, int c) { const int st = (r >> 4) * 2 + (c >> 5), rr = r & 15, cc = c & 31, ob = rr * 64 + cc * 2; return st * 1024 + (ob ^ (((ob >> 9) & 1) << 5)); }
__host__ __device__ __forceinline__ void stage_rc(int b, int& R, int& C) { const int st = b / 1024, sb = b % 1024, swz = sb ^ (((sb >> 9) & 1) << 5); R = (st >> 1) * 16 + swz / 64; C = (st & 1) * 32 + (swz % 64) / 2; }
__host__ __device__ __forceinline__ int perm32(int rho) { const int n = rho >> 4, i = rho & 15; return 8 * (i >> 2) + 4 * n + (i & 3); }
struct Unit { int pm, pn; };
struct Order {
  int nM, nN, nwg, G, c;
  __device__ void init(int nM_, int nN_, int G_, int c_) { nM = nM_; nN = nN_; nwg = nM * nN; G = G_; c = c_; }
  __device__ bool next(int i, Unit& u) const {
    const long L = (long)i * G + c; if (L >= nwg) return false;
    int wgid = (int)L; { const int q = nwg / NXCD, r = nwg % NXCD, xcd = wgid % NXCD, off = wgid / NXCD; wgid = (xcd < r ? xcd * (q + 1) : r * (q + 1) + (xcd - r) * q) + off; }
    const int nig = WGM * nN, gid = wgid / nig, fm = gid * WGM, gsz = (nM - fm) < WGM ? (nM - fm) : WGM;
    u.pm = fm + ((wgid % nig) % gsz); u.pn = (wgid % nig) / gsz; return true;
  }
};
enum { GEO_STD = 0, GEO_DFT1 = 1, GEO_DFT2 = 2, GEO_SPLITK = 3, GEO_A0 = 4 };
struct Geo {
  int mode; int lda, ldb; int aux;
  __device__ __forceinline__ size_t aoff(const Unit& u) const { if (mode == GEO_SPLITK) return (size_t)u.pm * BM * lda * 2 + (size_t)(u.pn >> 3) * aux * 2;
    return (mode == GEO_DFT1 || mode == GEO_A0) ? 0 : (size_t)u.pm * BM * lda * 2; }
  __device__ __forceinline__ size_t boff(const Unit& u) const {
    if (mode == GEO_STD) return (size_t)u.pn * BM * ldb * 2;
    if (mode == GEO_SPLITK) return (size_t)(u.pn & 7) * BM * ldb * 2 + (size_t)(u.pn >> 3) * aux * 2;
    if (mode == GEO_A0) return (size_t)u.pn * BM * ldb * 2;
    if (mode == GEO_DFT1) { const int tp = aux ? 1 : 16, seqlen = aux ? CTXL : SEQ; const int bg = u.pn / tp, pt = u.pn % tp, b = bg >> 3, g = bg & 7;
      return ((size_t)(b * seqlen + pt * (aux ? 256 : 4)) * 1024 + g * 128) * 2; }
    const int zl = aux ? 512 : 8192; const int b = u.pn >> 2, ct = u.pn & 3; return ((size_t)(b * 1024 + ct * 256) * zl) * 2;
  }
};

enum { E_IN = 0, E_DFT1, E_UQ, E_UKV, E_DFT2, E_GATE, E_Y, E_RES, E_UP, E_YC, E_FFTA, E_FFTC };
struct Epi {
  int mode; int pm_off, pn_off; int aux; int l; unsigned char* ws;
  __device__ __forceinline__ void operator()(const f32x4 (&acc)[2][2][4][2], const Unit& u, int wr, int wc, int fr_in, int fq_in) const {
    const int fr = opaque(fr_in), fq = opaque(fq_in);
    bf16_t *o0 = nullptr, *o1 = nullptr, *o2 = nullptr, *o3 = nullptr, *o4 = nullptr; const bf16_t* g0 = nullptr; float *s0 = nullptr, *s1 = nullptr; const float *c0 = nullptr, *c1 = nullptr;
    const float *xin_l = nullptr, *xin_c = nullptr; float *xout_l = nullptr, *xout_c = nullptr; int first = 0, seqlen = 0, tp = 1, zl = 0, rowbase = 0;
    switch (mode) {
      case E_IN: o0 = (bf16_t*)(ws + WS_UF); o1 = (bf16_t*)(ws + WS_VB); o2 = (bf16_t*)(ws + WS_QD); o3 = (bf16_t*)(ws + WS_KVD); o4 = (bf16_t*)(ws + WS_KPE);
        s0 = (float*)(ws + WS_SSQQ); s1 = (float*)(ws + WS_SSQKV); c0 = (const float*)(ws + WS_ROPEC); c1 = (const float*)(ws + WS_ROPES); break;
      case E_DFT1: o0 = (bf16_t*)(ws + (aux ? WS_ZTC : WS_ZT)); tp = aux ? 1 : 16; zl = aux ? 512 : 8192; break;
      case E_UQ: o0 = (bf16_t*)(ws + WS_Q); s0 = (float*)(ws + WS_SSQQ); c0 = (const float*)(ws + WS_ROPEC); c1 = (const float*)(ws + WS_ROPES); break;
      case E_UKV: o0 = (bf16_t*)(ws + WS_KN); o1 = (bf16_t*)(ws + WS_V); s1 = (float*)(ws + WS_SSQKV); break;
      case E_FFTA: o0 = (bf16_t*)(ws + WS_GP); c0 = (const float*)(ws + WS_TWC); c1 = (const float*)(ws + WS_TWS); break;
      case E_FFTC: o0 = (bf16_t*)(ws + WS_F); break;
      case E_DFT2: o0 = (bf16_t*)(ws + WS_F); seqlen = aux ? CTXL : SEQ; rowbase = aux ? MX : 0; break;
      case E_GATE: o0 = (aux & 4) ? (bf16_t*)(ws + WS_GATEC) + (size_t)(aux & 3) * 1024 * 2048 - (size_t)MX * 2048 : (bf16_t*)(ws + WS_TMPG); c0 = kargs()->b_gate + (size_t)l * 6144 + (aux & 3) * 2048; break;
      case E_YC: o0 = (bf16_t*)(ws + WS_YC) + (size_t)aux * 1024 * 2048 - (size_t)MX * 2048; break;
      case E_Y: o0 = (bf16_t*)(ws + WS_MERGED); g0 = (const bf16_t*)(ws + WS_TMPG); first = aux; break;
      case E_RES: { KArgP ka = kargs(); float* outp = ka->out; float* cx = (float*)(ws + WS_CTXX); const bool fresh = ((aux & 1) == 0 && l == 0);
        c0 = (const float*)(ws + WS_MODS) + (size_t)l * 5 * 12288 + ((aux & 1) ? 5 : 2) * 2048; xin_l = fresh ? ka->x : outp; xin_c = fresh ? ka->ctx : cx; xout_l = outp; xout_c = cx; break; }
      default: o0 = (bf16_t*)(ws + WS_HID); break;
    }
    const int pm = u.pm + pm_off, pn = u.pn + pn_off;
    const int cin = 32 * wc + 8 * fq;
    if (mode == E_IN) {
      if (pn < 4) {
#pragma unroll
        for (int ai = 0; ai < 2; ++ai)
#pragma unroll
          for (int m = 0; m < 4; ++m) { const int row = pm * 256 + ai * 128 + wr * 64 + m * 16 + fr;
#pragma unroll
            for (int bj = 0; bj < 2; ++bj) *(u32x4*)(o0 + (size_t)row * 1024 + pn * 256 + bj * 128 + cin) = pack8(acc[ai][bj][m][0], acc[ai][bj][m][1]); }
      } else if (pn < 12) {
        const int t = pn - 4;
#pragma unroll
        for (int ai = 0; ai < 2; ++ai)
#pragma unroll
          for (int m = 0; m < 4; ++m) { const int row = pm * 256 + ai * 128 + wr * 64 + m * 16 + fr;
            f32x4 v0, v1;
#pragma unroll
            for (int j = 0; j < 4; ++j) { v0[j] = acc[ai][0][m][0][j] * fsigmoid(acc[ai][1][m][0][j]); v1[j] = acc[ai][0][m][1][j] * fsigmoid(acc[ai][1][m][1][j]); }
            *(u32x4*)(o1 + (size_t)row * 1024 + t * 128 + cin) = pack8(v0, v1); }
      } else if (pn < 17) {
        const bool isq = pn < 15; bf16_t* ob = isq ? o2 : o3; const int ld = isq ? 768 : 512; const int ct = isq ? pn - 12 : pn - 15; float* ssq = isq ? s0 : s1;
#pragma unroll
        for (int ai = 0; ai < 2; ++ai)
#pragma unroll
          for (int m = 0; m < 4; ++m) { const int row = pm * 256 + ai * 128 + wr * 64 + m * 16 + fr; float s = 0.f;
#pragma unroll
            for (int bj = 0; bj < 2; ++bj) { const f32x4 a = acc[ai][bj][m][0], b = acc[ai][bj][m][1];
              s += (a[0] * a[0] + a[1] * a[1]) + (a[2] * a[2] + a[3] * a[3]) + (b[0] * b[0] + b[1] * b[1]) + (b[2] * b[2] + b[3] * b[3]);
              *(u32x4*)(ob + (size_t)row * ld + ct * 256 + bj * 128 + cin) = pack8(a, b); }
            s += __shfl_xor(s, 16); s += __shfl_xor(s, 32);
            if (fq == 0) atomicAdd(ssq + row, s); }
      } else {
        if (wc == 0) {
#pragma unroll
          for (int ai = 0; ai < 2; ++ai)
#pragma unroll
            for (int m = 0; m < 4; ++m) { const int row = pm * 256 + ai * 128 + wr * 64 + m * 16 + fr;
              f32x4 x1a = acc[ai][0][m][0], x1b = acc[ai][0][m][1], x2a = acc[ai][1][m][0], x2b = acc[ai][1][m][1], y1a = x1a, y1b = x1b, y2a = x2a, y2b = x2b;
              if (row < MX) { const int pos = row & 4095; const f32x4 ca = *(const f32x4*)(c0 + pos * 32 + cin), cb = *(const f32x4*)(c0 + pos * 32 + cin + 4), sa = *(const f32x4*)(c1 + pos * 32 + cin), sb = *(const f32x4*)(c1 + pos * 32 + cin + 4);
                y1a = x1a * ca - x2a * sa; y1b = x1b * cb - x2b * sb; y2a = x1a * sa + x2a * ca; y2b = x1b * sb + x2b * cb; }
              const int kr = kvrow(row);
              *(u32x4*)(o4 + (size_t)kr * 64 + cin) = pack8(y1a, y1b); *(u32x4*)(o4 + (size_t)kr * 64 + 32 + cin) = pack8(y2a, y2b); }
        }
      }
    } else if (mode == E_FFTA) {
      if (true) {
#pragma unroll
        for (int m2 = 0; m2 < 2; ++m2) { const int k1 = 32 * wr + 16 * m2 + fr;
#pragma unroll
          for (int bj = 0; bj < 2; ++bj) { const int nu = pn * 256 + bj * 128 + cin, n2 = nu & 63, chb = nu >> 6, ch = chb & 1023, b = chb >> 10;
            const f32x4 ca = *(const f32x4*)(c0 + k1 * 64 + n2), cb = *(const f32x4*)(c0 + k1 * 64 + n2 + 4), sa = *(const f32x4*)(c1 + k1 * 64 + n2), sb = *(const f32x4*)(c1 + k1 * 64 + n2 + 4);
            const f32x4 ra = acc[0][bj][m2][0], rb = acc[0][bj][m2][1], ia = acc[0][bj][m2 + 2][0], ib = acc[0][bj][m2 + 2][1];
            bf16_t* dst = o0 + ((size_t)((b * 64 + k1) * 1024 + ch)) * 128 + n2;
            *(u32x4*)dst = pack8(ra * ca + ia * sa, rb * cb + ib * sb); *(u32x4*)(dst + 64) = pack8(ia * ca - ra * sa, ib * cb - rb * sb); } }
      }
    } else if (mode == E_FFTC) {
      if (wr == 0) {
#pragma unroll
        for (int m = 0; m < 4; ++m) { const int k2 = 16 * m + fr;
#pragma unroll
          for (int bj = 0; bj < 2; ++bj) { const int nu = pn * 256 + bj * 128 + cin, ch = nu & 1023, k1 = (nu >> 10) & 63, b = nu >> 16;
            *(u32x4*)(o0 + ((size_t)(b * 4096 + k1 + 64 * k2)) * 1024 + ch) = pack8(acc[0][bj][m][0], acc[0][bj][m][1]); } }
      }
    } else if (mode == E_DFT1 && aux == 0) {
      const int bg = pn >> 4, pt = pn & 15, b = bg >> 3, g = bg & 7;
#pragma unroll
      for (int ai = 0; ai < 2; ++ai)
#pragma unroll
        for (int m = 0; m < 4; ++m) { const int l = wr * 64 + m * 16 + fr;
#pragma unroll
          for (int bj = 0; bj < 2; ++bj) { const int cl = bj * 128 + cin, n2 = 4 * pt + (cl >> 6), n1 = cl & 63;
            *(u32x4*)(o0 + ((size_t)((b * 1024 + g * 128 + l) * 64 + n2)) * 128 + ai * 64 + n1) = pack8(acc[ai][bj][m][0], acc[ai][bj][m][1]); } }
    } else if (mode == E_DFT1) {
      const int bg = pn / tp, pt = pn % tp, b = bg >> 3, g = bg & 7;
#pragma unroll
      for (int ai = 0; ai < 2; ++ai)
#pragma unroll
        for (int m = 0; m < 4; ++m) { const int l = wr * 64 + m * 16 + fr;
#pragma unroll
          for (int bj = 0; bj < 2; ++bj) *(u32x4*)(o0 + (size_t)(b * 1024 + g * 128 + l) * zl + ai * (zl >> 1) + pt * 256 + bj * 128 + cin) = pack8(acc[ai][bj][m][0], acc[ai][bj][m][1]); }
    } else if (mode == E_UQ) {
#pragma unroll
      for (int ai = 0; ai < 2; ++ai)
#pragma unroll
        for (int m = 0; m < 4; ++m) { const int row = pm * 256 + ai * 128 + wr * 64 + m * 16 + fr; const float rs = 1.0f / sqrtf(s0[row] * (1.f / 768.f) + EPS);
          if (pn < 8) {
#pragma unroll
            for (int bj = 0; bj < 2; ++bj) *(u32x4*)(o0 + (size_t)row * 3072 + (2 * pn + bj) * 192 + cin) = pack8(acc[ai][bj][m][0] * rs, acc[ai][bj][m][1] * rs);
          } else {
            const int head = 4 * (pn - 8) + wc, i0 = 8 * fq;
            f32x4 x1a = acc[ai][0][m][0] * rs, x1b = acc[ai][0][m][1] * rs, x2a = acc[ai][1][m][0] * rs, x2b = acc[ai][1][m][1] * rs, y1a = x1a, y1b = x1b, y2a = x2a, y2b = x2b;
            if (row < MX) { const int pos = row & 4095; const f32x4 ca = *(const f32x4*)(c0 + pos * 32 + i0), cb = *(const f32x4*)(c0 + pos * 32 + i0 + 4), sa = *(const f32x4*)(c1 + pos * 32 + i0), sb = *(const f32x4*)(c1 + pos * 32 + i0 + 4);
              y1a = x1a * ca - x2a * sa; y1b = x1b * cb - x2b * sb; y2a = x1a * sa + x2a * ca; y2b = x1b * sb + x2b * cb; }
            *(u32x4*)(o0 + (size_t)row * 3072 + head * 192 + 128 + i0) = pack8(y1a, y1b); *(u32x4*)(o0 + (size_t)row * 3072 + head * 192 + 160 + i0) = pack8(y2a, y2b);
          } }
    } else if (mode == E_UKV) {
      bf16_t* ob = pn < 8 ? o0 : o1; const int ct = pn < 8 ? pn : pn - 8;
#pragma unroll
      for (int ai = 0; ai < 2; ++ai)
#pragma unroll
        for (int m = 0; m < 4; ++m) { const int row = pm * 256 + ai * 128 + wr * 64 + m * 16 + fr; const float rs = 1.0f / sqrtf(s1[row] * (1.f / 512.f) + EPS); const int kr = kvrow(row);
#pragma unroll
          for (int bj = 0; bj < 2; ++bj) *(u32x4*)(ob + (size_t)kr * 2048 + ct * 256 + bj * 128 + cin) = pack8(acc[ai][bj][m][0] * rs, acc[ai][bj][m][1] * rs); }
    } else if (mode == E_DFT2) {
      const int b = pn >> 2, ct = pn & 3;
#pragma unroll
      for (int ai = 0; ai < 2; ++ai)
#pragma unroll
        for (int m = 0; m < 4; ++m) { const int row = rowbase + b * seqlen + pm * 256 + ai * 128 + wr * 64 + m * 16 + fr;
#pragma unroll
          for (int bj = 0; bj < 2; ++bj) *(u32x4*)(o0 + (size_t)row * 1024 + ct * 256 + bj * 128 + cin) = pack8(acc[ai][bj][m][0], acc[ai][bj][m][1]); }
    } else if (mode == E_GATE) {
#pragma unroll
      for (int bj = 0; bj < 2; ++bj) { const int col = pn * 256 + bj * 128 + cin; const f32x4 ba = *(const f32x4*)(c0 + col), bb = *(const f32x4*)(c0 + col + 4);
#pragma unroll
        for (int ai = 0; ai < 2; ++ai)
#pragma unroll
          for (int m = 0; m < 4; ++m) { const int row = pm * 256 + ai * 128 + wr * 64 + m * 16 + fr; f32x4 v0, v1;
#pragma unroll
            for (int j = 0; j < 4; ++j) { v0[j] = fsigmoid(acc[ai][bj][m][0][j] + ba[j]); v1[j] = fsigmoid(acc[ai][bj][m][1][j] + bb[j]); }
            *(u32x4*)(o0 + (size_t)row * 2048 + col) = pack8(v0, v1); } }
    } else if (mode == E_Y) {
#pragma unroll
      for (int am = 0; am < 4; ++am) { const int ai = am >> 1, mb = (am & 1) * 2; u32x4 gw[2][2], mw[2][2];
#pragma unroll
        for (int mm = 0; mm < 2; ++mm)
#pragma unroll
          for (int bj = 0; bj < 2; ++bj) { const int row = pm * 256 + ai * 128 + wr * 64 + (mb + mm) * 16 + fr; const size_t off = (size_t)row * 2048 + pn * 256 + bj * 128 + cin;
            gw[mm][bj] = *(const u32x4*)(g0 + off); mw[mm][bj] = first ? (u32x4){0u, 0u, 0u, 0u} : *(const u32x4*)(o0 + off); }
        asm volatile("" ::: "memory");
#pragma unroll
        for (int mm = 0; mm < 2; ++mm)
#pragma unroll
          for (int bj = 0; bj < 2; ++bj) { const int m = mb + mm; const int row = pm * 256 + ai * 128 + wr * 64 + m * 16 + fr; const size_t off = (size_t)row * 2048 + pn * 256 + bj * 128 + cin; const u32x4 g_ = gw[mm][bj], m_ = mw[mm][bj];
            f32x4 v0, v1; v0[0] = bflo(g_.x) * acc[ai][bj][m][0][0] + bflo(m_.x); v0[1] = bfhi(g_.x) * acc[ai][bj][m][0][1] + bfhi(m_.x); v0[2] = bflo(g_.y) * acc[ai][bj][m][0][2] + bflo(m_.y); v0[3] = bfhi(g_.y) * acc[ai][bj][m][0][3] + bfhi(m_.y);
            v1[0] = bflo(g_.z) * acc[ai][bj][m][1][0] + bflo(m_.z); v1[1] = bfhi(g_.z) * acc[ai][bj][m][1][1] + bfhi(m_.z); v1[2] = bflo(g_.w) * acc[ai][bj][m][1][2] + bflo(m_.w); v1[3] = bfhi(g_.w) * acc[ai][bj][m][1][3] + bfhi(m_.w);
            *(u32x4*)(o0 + off) = pack8(v0, v1); }
        asm volatile("" ::: "memory"); }
    } else if (mode == E_YC) {
#pragma unroll
      for (int ai = 0; ai < 2; ++ai)
#pragma unroll
        for (int m = 0; m < 4; ++m) { const int row = pm * 256 + ai * 128 + wr * 64 + m * 16 + fr;
#pragma unroll
          for (int bj = 0; bj < 2; ++bj) *(u32x4*)(o0 + (size_t)row * 2048 + pn * 256 + bj * 128 + cin) = pack8(acc[ai][bj][m][0], acc[ai][bj][m][1]); }
    } else if (mode == E_RES) {
      if (aux & 8) {
        float* pb = (float*)(ws + WS_PART) + (size_t)(pn >> 3) * 1024 * 2048; const int pnn = pn & 7;
#pragma unroll
        for (int ai = 0; ai < 2; ++ai)
#pragma unroll
          for (int m = 0; m < 4; ++m) { const int row = pm * 256 + ai * 128 + wr * 64 + m * 16 + fr - MX;
#pragma unroll
            for (int bj = 0; bj < 2; ++bj) { float* q = pb + (size_t)row * 2048 + pnn * 256 + bj * 128 + cin; *(f32x4*)q = acc[ai][bj][m][0]; *(f32x4*)(q + 4) = acc[ai][bj][m][1]; } }
        return;
      }
      {
        const int row0 = pm * 256; const bool lat = row0 < MX; const int mg = modgrp(row0);
        const float* xi0 = lat ? xin_l + (size_t)row0 * 2048 : xin_c + (size_t)(row0 - MX) * 2048; float* xo0 = lat ? xout_l + (size_t)row0 * 2048 : xout_c + (size_t)(row0 - MX) * 2048;
        f32x4 ga[2], gb[2];
#pragma unroll
        for (int bj = 0; bj < 2; ++bj) { const int col = pn * 256 + bj * 128 + cin; ga[bj] = *(const f32x4*)(c0 + mg * 12288 + col); gb[bj] = *(const f32x4*)(c0 + mg * 12288 + col + 4); }
#pragma unroll
        for (int am = 0; am < 4; ++am) { const int ai = am >> 1, mb = (am & 1) * 2; f32x4 xa[2][2], xb[2][2];
#pragma unroll
          for (int mm = 0; mm < 2; ++mm)
#pragma unroll
            for (int bj = 0; bj < 2; ++bj) { const size_t off = (size_t)(ai * 128 + wr * 64 + (mb + mm) * 16 + fr) * 2048 + pn * 256 + bj * 128 + cin; xa[mm][bj] = *(const f32x4*)(xi0 + off); xb[mm][bj] = *(const f32x4*)(xi0 + off + 4); }
          asm volatile("" ::: "memory");
#pragma unroll
          for (int mm = 0; mm < 2; ++mm)
#pragma unroll
            for (int bj = 0; bj < 2; ++bj) { const size_t off = (size_t)(ai * 128 + wr * 64 + (mb + mm) * 16 + fr) * 2048 + pn * 256 + bj * 128 + cin;
              *(f32x4*)(xo0 + off) = xa[mm][bj] + ga[bj] * acc[ai][bj][mb + mm][0]; *(f32x4*)(xo0 + off + 4) = xb[mm][bj] + gb[bj] * acc[ai][bj][mb + mm][1]; }
          asm volatile("" ::: "memory"); }
      }
    } else {
#pragma unroll
      for (int ai = 0; ai < 2; ++ai)
#pragma unroll
        for (int m = 0; m < 4; ++m) { const int row = pm * 256 + ai * 128 + wr * 64 + m * 16 + fr; f32x4 v0, v1;
#pragma unroll
          for (int j = 0; j < 4; ++j) { const float a = acc[ai][0][m][0][j], b = acc[ai][0][m][1][j]; v0[j] = a * fsigmoid(a) * acc[ai][1][m][0][j]; v1[j] = b * fsigmoid(b) * acc[ai][1][m][1][j]; }
          *(u32x4*)(o0 + (size_t)row * FFH + pn * 128 + cin) = pack8(v0, v1); }
    }
  }
};

__device__ __forceinline__ void gemm_phase(LAS unsigned char* lds, const bf16_t* Aop, const bf16_t* Bop, int K, const Order& S, const Geo& geo, const Epi& E) {
  const int tid = opaque(threadIdx.x), wid = __builtin_amdgcn_readfirstlane(tid >> 6), lane = tid & 63, wr = wid >> 2, wc = wid & 3, fr = lane & 15, fq = lane >> 4;
  const int nt = K / BK;
  unsigned voffA[2], voffB[2];
  const bool rperm = (geo.mode == GEO_DFT1 && geo.aux == 0);
#pragma unroll
  for (int i = 0; i < 2; ++i) { int R, C; stage_rc(tid * 16 + i * 8192, R, C); const int Rb = (R & ~31) + perm32(R & 31); const int Rg = rperm ? 64 * (Rb & 63) + (Rb >> 6) : Rb;
    voffA[i] = (unsigned)(R * geo.lda + C) * 2u; voffB[i] = (unsigned)(Rg * geo.ldb + C) * 2u; }
  const size_t kstep = (size_t)(BK * 2);
  const size_t hstepA = (size_t)HALF * geo.lda * 2, hstepB = rperm ? (size_t)2 * geo.ldb * 2 : (size_t)HALF * geo.ldb * 2;
  const unsigned ldsw = (unsigned)wid * 1024u;
  const int aoff = lds_byte(wr * 64 + fr, fq * 8), boff = lds_byte(wc * 32 + fr, fq * 8);
#define PG8_SA(b, h) (((b) * 2 + (h)) * HTB)
#define PG8_SB(b, h) ((4 + (b) * 2 + (h)) * HTB)
#define PG8_STAGE(bufoff, gbase, voff) do { _Pragma("unroll") for (int _i = 0; _i < 2; ++_i) \
        __builtin_amdgcn_global_load_lds((const unsigned*)((const char*)(gbase) + (voff)[_i]), (LAS unsigned*)(lds + (bufoff) + ldsw + _i * 8192), 16, 0, 0); } while (0)
#define PG8_LDA(dst, b, h) do { _Pragma("unroll") for (int m = 0; m < 4; ++m) _Pragma("unroll") for (int k = 0; k < 2; ++k) dst[m][k] = *(const LAS bf16x8*)(lds + PG8_SA(b, h) + aoff + m * 2048 + k * 1024); } while (0)
#define PG8_LDB(dst, b, h) do { _Pragma("unroll") for (int n = 0; n < 2; ++n) _Pragma("unroll") for (int k = 0; k < 2; ++k) dst[n][k] = *(const LAS bf16x8*)(lds + PG8_SB(b, h) + boff + n * 2048 + k * 1024); } while (0)
#define PG8_MMA(ai, bj, At, Bt) do { __builtin_amdgcn_s_setprio(1); _Pragma("unroll") for (int m = 0; m < 4; ++m) _Pragma("unroll") for (int n = 0; n < 2; ++n) _Pragma("unroll") for (int k = 0; k < 2; ++k) \
        acc[ai][bj][m][n] = __builtin_amdgcn_mfma_f32_16x16x32_bf16(Bt[n][k], At[m][k], acc[ai][bj][m][n], 0, 0, 0); __builtin_amdgcn_s_setprio(0); } while (0)
#define PG8_WAIT_V(n) asm volatile("s_waitcnt vmcnt(" #n ")" ::: "memory")
#define PG8_WAIT_L(n) asm volatile("s_waitcnt lgkmcnt(" #n ")" ::: "memory")
#define PG8_BAR __builtin_amdgcn_s_barrier()
#define PG8_SCHED __builtin_amdgcn_sched_barrier(0)
  Unit cur, nxt; int ui = 0;
  if (!S.next(0, cur)) return;
  f32x4 acc[2][2][4][2];
#pragma unroll
  for (int a = 0; a < 2; ++a)
#pragma unroll
    for (int b = 0; b < 2; ++b)
#pragma unroll
      for (int m = 0; m < 4; ++m)
#pragma unroll
        for (int n = 0; n < 2; ++n) acc[a][b][m][n] = (f32x4){0.f, 0.f, 0.f, 0.f};
  bf16x8 At[4][2], B0[2][2], B1[2][2];
  const char* cA = (const char*)Aop + geo.aoff(cur); const char* cB = (const char*)Bop + geo.boff(cur);
  PG8_STAGE(PG8_SB(0, 0), cB, voffB); PG8_STAGE(PG8_SB(0, 1), cB + hstepB, voffB); PG8_STAGE(PG8_SA(0, 0), cA, voffA); PG8_STAGE(PG8_SA(0, 1), cA + hstepA, voffA);
  if (wr == 1) PG8_BAR;
  PG8_WAIT_V(2); PG8_BAR;
  PG8_STAGE(PG8_SB(1, 0), cB + kstep, voffB); PG8_STAGE(PG8_SA(1, 0), cA + kstep, voffA); PG8_STAGE(PG8_SB(1, 1), cB + hstepB + kstep, voffB);
  PG8_WAIT_V(6); PG8_BAR;
  for (;;) {
    const bool has_next = S.next(ui + 1, nxt);
    const char* nA = has_next ? (const char*)Aop + geo.aoff(nxt) : cA; const char* nB = has_next ? (const char*)Bop + geo.boff(nxt) : cB;
    for (int t = 0; t < nt; t += 2) {
      const bool last = (t == nt - 2);
      const char* a1 = cA + (size_t)(t + 1) * kstep;
      const char* a2 = last ? nA : cA + (size_t)(t + 2) * kstep; const char* b2 = last ? nB : cB + (size_t)(t + 2) * kstep;
      const char* a3 = a2 + kstep; const char* b3 = b2 + kstep;
      PG8_LDB(B0, 0, 0); PG8_LDB(B1, 0, 1); PG8_SCHED; PG8_LDA(At, 0, 0); PG8_STAGE(PG8_SA(1, 1), a1 + hstepA, voffA);
      PG8_WAIT_V(8); PG8_WAIT_L(0); PG8_BAR; PG8_MMA(0, 0, At, B0); PG8_MMA(0, 1, At, B1); PG8_BAR; PG8_SCHED;
      PG8_LDA(At, 0, 1); PG8_STAGE(PG8_SB(0, 0), b2, voffB); PG8_STAGE(PG8_SB(0, 1), b2 + hstepB, voffB); PG8_STAGE(PG8_SA(0, 0), a2, voffA);
      PG8_WAIT_V(8); PG8_WAIT_L(0); PG8_BAR; PG8_MMA(1, 0, At, B0); PG8_MMA(1, 1, At, B1); PG8_BAR; PG8_SCHED;
      PG8_LDB(B0, 1, 0); PG8_LDB(B1, 1, 1); PG8_SCHED; PG8_LDA(At, 1, 0); PG8_STAGE(PG8_SA(0, 1), a2 + hstepA, voffA);
      PG8_WAIT_V(8); PG8_WAIT_L(0); PG8_BAR; PG8_MMA(0, 0, At, B0); PG8_MMA(0, 1, At, B1); PG8_BAR; PG8_SCHED;
      PG8_LDA(At, 1, 1); PG8_STAGE(PG8_SB(1, 0), b3, voffB); PG8_STAGE(PG8_SB(1, 1), b3 + hstepB, voffB); PG8_STAGE(PG8_SA(1, 0), a3, voffA);
      PG8_WAIT_V(8); PG8_WAIT_L(0); PG8_BAR; PG8_MMA(1, 0, At, B0); PG8_MMA(1, 1, At, B1); PG8_BAR; PG8_SCHED;
    }
    if (wr == 0) PG8_BAR;
    E(acc, cur, wr, wc, fr, fq);
    if (!has_next) break;
#pragma unroll
    for (int a = 0; a < 2; ++a)
#pragma unroll
      for (int b = 0; b < 2; ++b)
#pragma unroll
        for (int m = 0; m < 4; ++m)
#pragma unroll
          for (int n = 0; n < 2; ++n) acc[a][b][m][n] = (f32x4){0.f, 0.f, 0.f, 0.f};
    cur = nxt; cA = nA; cB = nB; ++ui;
    if (wr == 1) PG8_BAR;
  }
  PG8_WAIT_V(0);
  PG8_BAR;
#undef PG8_SA
#undef PG8_SB
#undef PG8_STAGE
#undef PG8_LDA
#undef PG8_LDB
#undef PG8_MMA
#undef PG8_WAIT_V
#undef PG8_WAIT_L
#undef PG8_BAR
#undef PG8_SCHED
}
}

namespace att {
constexpr int NW = 8, QBLK = 32, KVBLK = 64;
constexpr float SCALE = 0.07216878364870322f;
constexpr float THR = 8.f;
constexpr int SDEPTH = 1;
constexpr int LDQ = 3072, LDK = 2048, LDKP = 64, LDO = 2048;
constexpr int SHM_V = 16384, SHM_K = 16384, SHM_KP = 8192;
constexpr int OFF_V = 0, OFF_K = 2 * SHM_V, OFF_KP = OFF_K + 2 * SHM_K, OFF_WS = OFF_KP + 2 * SHM_KP, OFF_QP = OFF_WS + NW * 64 * 4, QP_WAVE = 32 * 144, SHM_ATTN = OFF_QP + NW * QP_WAVE;
#define KSWZ(row, colB) ((row) * 256 + ((colB) ^ (((row) & 15) << 4)))
#define KPSWZ(row, colB) ((row) * 128 + ((colB) ^ ((((row) >> 1) & 7) << 4)))
#define SBAR() __builtin_amdgcn_sched_barrier(0)
__device__ __forceinline__ int crow(int r, int hi) { return (r & 3) + 8 * (r >> 2) + 4 * hi; }
__device__ __forceinline__ void partialSM(f32x16& p0, f32x16& p1, float& m_reg, float& mn, float& alpha) {
  constexpr float C = SCALE * 1.4426950408889634f;
#define MX3(a, b, c) __builtin_fmaxf(__builtin_fmaxf((a), (b)), (c))
  float ma = MX3(p0[0], p0[1], p1[0]), mb = MX3(p0[2], p0[3], p1[1]); ma = MX3(ma, p1[2], p1[3]);
#pragma unroll
  for (int r = 4; r < 16; r += 4) { ma = MX3(ma, p0[r], p0[r + 1]); mb = MX3(mb, p0[r + 2], p0[r + 3]); ma = MX3(ma, p1[r], p1[r + 1]); mb = MX3(mb, p1[r + 2], p1[r + 3]); }
  float pmax = __builtin_fmaxf(ma, mb);
#undef MX3
  { auto rr = __builtin_amdgcn_permlane32_swap(__float_as_uint(pmax), __float_as_uint(pmax), false, false);
    pmax = fmaxf(__uint_as_float(rr[0]), __uint_as_float(rr[1])); }
  if (__builtin_expect(__all(pmax - m_reg <= THR / SCALE), 1)) { mn = m_reg; alpha = 1.f; }
  else { mn = fmaxf(m_reg, pmax); alpha = __builtin_amdgcn_exp2f((m_reg - mn) * C); m_reg = mn; }
  float mnC = -mn * C;
#pragma unroll
  for (int r = 0; r < 16; ++r) p0[r] = fmaf(p0[r], C, mnC);
#pragma unroll
  for (int r = 0; r < 16; ++r) p1[r] = fmaf(p1[r], C, mnC);
#pragma unroll
  for (int r = 0; r < 16; ++r) p0[r] = __builtin_amdgcn_exp2f(p0[r]);
}
__device__ __forceinline__ void finishSM(f32x16& p0, f32x16& p1, float alpha, float& l_reg, bf16x8& pa0, bf16x8& pa1, bf16x8& pa2, bf16x8& pa3) {
#pragma unroll
  for (int r = 0; r < 16; ++r) p1[r] = __builtin_amdgcn_exp2f(p1[r]);
  float ps0 = 0.f, ps1 = 0.f, ps2 = 0.f, ps3 = 0.f;
#pragma unroll
  for (int r = 0; r < 16; r += 4) { ps0 += p0[r] + p1[r]; ps1 += p0[r + 1] + p1[r + 1]; ps2 += p0[r + 2] + p1[r + 2]; ps3 += p0[r + 3] + p1[r + 3]; }
  float ps = (ps0 + ps1) + (ps2 + ps3);
  { auto rr = __builtin_amdgcn_permlane32_swap(__float_as_uint(ps), __float_as_uint(ps), false, false);
    ps = __uint_as_float(rr[0]) + __uint_as_float(rr[1]); }
  l_reg = l_reg * alpha + ps;
#define PK4(P, BASE, OUT) do { unsigned a0 = cvt_pk(P[BASE + 0], P[BASE + 1]), a1 = cvt_pk(P[BASE + 2], P[BASE + 3]);   \
    unsigned b0 = cvt_pk(P[BASE + 4], P[BASE + 5]), b1 = cvt_pk(P[BASE + 6], P[BASE + 7]);                              \
    auto r0 = __builtin_amdgcn_permlane32_swap(a0, b0, false, false); auto r1 = __builtin_amdgcn_permlane32_swap(a1, b1, false, false); \
    u32x4 w = {r0[0], r1[0], r0[1], r1[1]}; OUT = *reinterpret_cast<bf16x8*>(&w); } while (0)
  PK4(p0, 0, pa0); PK4(p0, 8, pa1); PK4(p1, 0, pa2); PK4(p1, 8, pa3);
#undef PK4
}
__device__ __forceinline__ void qkt(f32x16& p0, f32x16& p1, const char* Ks, const char* KPs, const char* QPs, const bf16x8* qr, int r32, int hi) {
  p0 = f32x16{}; p1 = f32x16{};
  const char* qrow = QPs + r32 * 144 + hi * 16;
#pragma unroll
  for (int d0 = 0; d0 < 8; ++d0) { int cb = (d0 * 16 + hi * 8) * 2;
    bf16x8 b0 = *reinterpret_cast<const bf16x8*>(Ks + KSWZ(r32, cb));
    bf16x8 b1 = *reinterpret_cast<const bf16x8*>(Ks + KSWZ(32 + r32, cb));
    const bf16x8 qf = qr[d0];
    p0 = __builtin_amdgcn_mfma_f32_32x32x16_bf16(b0, qf, p0, 0, 0, 0);
    p1 = __builtin_amdgcn_mfma_f32_32x32x16_bf16(b1, qf, p1, 0, 0, 0); }
#pragma unroll
  for (int d0 = 0; d0 < 4; ++d0) { int cb = (d0 * 16 + hi * 8) * 2;
    bf16x8 b0 = *reinterpret_cast<const bf16x8*>(KPs + KPSWZ(r32, cb));
    bf16x8 b1 = *reinterpret_cast<const bf16x8*>(KPs + KPSWZ(32 + r32, cb));
    bf16x8 qf = *reinterpret_cast<const bf16x8*>(qrow + d0 * 32);
    p0 = __builtin_amdgcn_mfma_f32_32x32x16_bf16(b0, qf, p0, 0, 0, 0);
    p1 = __builtin_amdgcn_mfma_f32_32x32x16_bf16(b1, qf, p1, 0, 0, 0); }
}
__device__ __forceinline__ int v_st(int k, int c) { const int kk = (k & ~0xC) | ((k & 4) << 1) | ((k & 8) >> 1); return ((kk >> 3) * 4 + (c >> 5)) * 512 + ((kk & 7) * 32 + (c & 31)) * 2; }
__device__ __forceinline__ int v_rd_base(int lane) { return ((lane & 3) << 3) | (((lane >> 2) & 3) << 6) | (((lane >> 4) & 1) << 5) | (((lane >> 5) & 1) << 8); }
constexpr int v_rd_off(int d0, int ks, int half) { return d0 * 512 + ks * 4096 + half * 2048; }
template <int OFF> __device__ __forceinline__ s16x4 tr_read(int vb) {
  s16x4 r; asm volatile("ds_read_b64_tr_b16 %0, %1 offset:%2" : "=&v"(r) : "v"(vb), "i"(OFF) : "memory"); return r;
}
#define PV_READ(D0, KH, L, H) do { L[0] = tr_read<v_rd_off(D0, 2 * KH, 0)>(vb); H[0] = tr_read<v_rd_off(D0, 2 * KH, 1)>(vb); L[1] = tr_read<v_rd_off(D0, 2 * KH + 1, 0)>(vb); H[1] = tr_read<v_rd_off(D0, 2 * KH + 1, 1)>(vb); } while (0)
#define PV_PK(L, H) (bf16x8){L[0], L[1], L[2], L[3], H[0], H[1], H[2], H[3]}
#define PV_MMA(OD, PX, PY, L, H) do { OD = __builtin_amdgcn_mfma_f32_32x32x16_bf16(PX, PV_PK(L[0], H[0]), OD, 0, 0, 0); OD = __builtin_amdgcn_mfma_f32_32x32x16_bf16(PY, PV_PK(L[1], H[1]), OD, 0, 0, 0); } while (0)
#define PV_W4() do { asm volatile("s_waitcnt lgkmcnt(4)" ::: "memory"); SBAR(); } while (0)
__device__ __forceinline__ void pv_d0(f32x16* o, int vb, bf16x8 pa0, bf16x8 pa1, bf16x8 pa2, bf16x8 pa3) {
  s16x4 la[2], ha[2], lb[2], hb[2];
  PV_READ(0, 0, la, ha);
  PV_READ(0, 1, lb, hb); PV_W4(); PV_MMA(o[0], pa0, pa1, la, ha); SBAR();
  PV_READ(1, 0, la, ha); PV_W4(); PV_MMA(o[0], pa2, pa3, lb, hb); SBAR();
  PV_READ(1, 1, lb, hb); PV_W4(); PV_MMA(o[1], pa0, pa1, la, ha); SBAR();
  PV_READ(2, 0, la, ha); PV_W4(); PV_MMA(o[1], pa2, pa3, lb, hb); SBAR();
  PV_READ(2, 1, lb, hb); PV_W4(); PV_MMA(o[2], pa0, pa1, la, ha); SBAR();
  PV_READ(3, 0, la, ha); PV_W4(); PV_MMA(o[2], pa2, pa3, lb, hb); SBAR();
  PV_READ(3, 1, lb, hb); PV_W4(); PV_MMA(o[3], pa0, pa1, la, ha); SBAR();
  asm volatile("s_waitcnt lgkmcnt(0)" ::: "memory"); SBAR(); PV_MMA(o[3], pa2, pa3, lb, hb);
}
#undef PV_READ
#undef PV_W4
__device__ __forceinline__ void attn_body(const bf16_t* __restrict__ Qb, const bf16_t* __restrict__ Kh, const bf16_t* __restrict__ KPh, const bf16_t* __restrict__ Vh,
                                          bf16_t* __restrict__ Ob, int seq, char* lds) {
  const int tid = opaque(threadIdx.x), wid = tid >> 6, lane = tid & 63, r32 = lane & 31, hi = lane >> 5;
  char* V_lds = lds + OFF_V; char* K_lds = lds + OFF_K; char* KP_lds = lds + OFF_KP;
  float* ws = (float*)(lds + OFF_WS) + wid * 64; float* li_l = ws; float* al_l = ws + 32;
  float m_reg = -1e30f, l_reg = 0; f32x16 o[4] = {}; bf16x8 qr[8];
  char* QP_lds = lds + OFF_QP + wid * QP_WAVE;
  const bf16_t* Qw = Qb + (long)(wid * QBLK + r32) * LDQ + hi * 8;
#pragma unroll
  for (int d0 = 0; d0 < 8; ++d0) qr[d0] = *reinterpret_cast<const bf16x8*>(Qw + d0 * 16);
#pragma unroll
  for (int d0 = 8; d0 < 12; ++d0) *reinterpret_cast<bf16x8*>(QP_lds + r32 * 144 + hi * 16 + (d0 - 8) * 32) = *reinterpret_cast<const bf16x8*>(Qw + d0 * 16);
  const int sr = tid >> 4, sc = (tid & 15) * 8, vst0 = v_st(sr, sc), vst1 = v_st(32 + sr, sc);
  const int pr = tid >> 3, pc = (tid & 7) * 8;
  const int vb0 = (int)(uintptr_t)V_lds + v_rd_base(lane);
  struct { bf16x8 vs0, vs1, ks0, ks1, kp; } sr_[SDEPTH];
#define SLOAD(i, k0) do { sr_[i].vs0 = *reinterpret_cast<const bf16x8*>(&Vh[(long)((k0) + sr) * LDK + sc]); sr_[i].vs1 = *reinterpret_cast<const bf16x8*>(&Vh[(long)((k0) + 32 + sr) * LDK + sc]); \
    sr_[i].ks0 = *reinterpret_cast<const bf16x8*>(&Kh[(long)((k0) + sr) * LDK + sc]); sr_[i].ks1 = *reinterpret_cast<const bf16x8*>(&Kh[(long)((k0) + 32 + sr) * LDK + sc]); \
    sr_[i].kp = *reinterpret_cast<const bf16x8*>(&KPh[(long)((k0) + pr) * LDKP + pc]); } while (0)
#define SWRITE(b, i) do { *(bf16x8*)(V_lds + (b) * SHM_V + vst0) = sr_[i].vs0;          \
    *(bf16x8*)(V_lds + (b) * SHM_V + vst1) = sr_[i].vs1; int kc = sc * 2;               \
    *(bf16x8*)(K_lds + (b) * SHM_K + KSWZ(sr, kc)) = sr_[i].ks0;                       \
    *(bf16x8*)(K_lds + (b) * SHM_K + KSWZ(32 + sr, kc)) = sr_[i].ks1;                  \
    *(bf16x8*)(KP_lds + (b) * SHM_KP + KPSWZ(pr, pc * 2)) = sr_[i].kp; } while (0)
#define SWAIT() do { if constexpr (SDEPTH == 2) asm volatile("s_waitcnt vmcnt(5)" ::: "memory"); else asm volatile("s_waitcnt vmcnt(0)" ::: "memory"); } while (0)
#define RESC(a) do { if (__any((a) < 1.f)) { if (hi == 0) al_l[r32] = (a); asm volatile("s_waitcnt lgkmcnt(0)" ::: "memory"); \
    _Pragma("unroll") for (int d = 0; d < 4; ++d) _Pragma("unroll") for (int r = 0; r < 16; ++r) o[d][r] *= al_l[crow(r, hi)]; } } while (0)
  f32x16 pA0, pA1, pB0, pB1; float mnA, mnB, alA, alB; bf16x8 pa0, pa1, pa2, pa3; const int NT = seq / KVBLK;
  constexpr int SE = 0, SO = SDEPTH - 1;
  SLOAD(SE, 0); asm volatile("s_waitcnt vmcnt(0)" ::: "memory"); SWRITE(0, SE); __syncthreads();
  qkt(pA0, pA1, K_lds, KP_lds, QP_lds, qr, r32, hi); partialSM(pA0, pA1, m_reg, mnA, alA);
  SLOAD(SO, KVBLK); if constexpr (SDEPTH == 2) { if (2 < NT) SLOAD(SE, 2 * KVBLK); }
  SWAIT(); SWRITE(1, SO); __syncthreads();
  for (int j = 1; j + 1 < NT; j += 2) {
    SBAR(); qkt(pB0, pB1, K_lds + SHM_K, KP_lds + SHM_KP, QP_lds, qr, r32, hi);
    finishSM(pA0, pA1, alA, l_reg, pa0, pa1, pa2, pa3); SBAR();
    SLOAD(SO, (j + SDEPTH) * KVBLK); SBAR();
    pv_d0(o, vb0, pa0, pa1, pa2, pa3); partialSM(pB0, pB1, m_reg, mnB, alB);
    __syncthreads(); SWAIT(); SWRITE(0, SE);
    RESC(alB); __syncthreads();
    SBAR(); qkt(pA0, pA1, K_lds, KP_lds, QP_lds, qr, r32, hi);
    finishSM(pB0, pB1, alB, l_reg, pa0, pa1, pa2, pa3); SBAR();
    if (SDEPTH == 1 || j + 3 < NT) SLOAD(SE, (j + 1 + SDEPTH) * KVBLK); SBAR();
    pv_d0(o, vb0 + SHM_V, pa0, pa1, pa2, pa3); partialSM(pA0, pA1, m_reg, mnA, alA);
    __syncthreads(); SWAIT(); SWRITE(1, SO);
    RESC(alA); __syncthreads();
  }
  SBAR(); qkt(pB0, pB1, K_lds + SHM_K, KP_lds + SHM_KP, QP_lds, qr, r32, hi);
  finishSM(pA0, pA1, alA, l_reg, pa0, pa1, pa2, pa3); SBAR();
  pv_d0(o, vb0, pa0, pa1, pa2, pa3); partialSM(pB0, pB1, m_reg, mnB, alB);
  __syncthreads(); RESC(alB);
  finishSM(pB0, pB1, alB, l_reg, pa0, pa1, pa2, pa3); SBAR();
  pv_d0(o, vb0 + SHM_V, pa0, pa1, pa2, pa3);
  if (hi == 0) li_l[r32] = l_reg; asm volatile("s_waitcnt lgkmcnt(0)" ::: "memory");
  float rli[16];
#pragma unroll
  for (int r = 0; r < 16; ++r) rli[r] = __builtin_amdgcn_rcpf(li_l[crow(r, hi)]);
  bf16_t* Ow = Ob + (long)(wid * QBLK) * LDO;
#pragma unroll
  for (int r = 0; r < 16; ++r) { int orow = crow(r, hi);
#pragma unroll
    for (int d0 = 0; d0 < 4; ++d0) Ow[(long)orow * LDO + d0 * 32 + r32] = (bf16_t)(cvt_pk(o[d0][r] * rli[r], 0.f) & 0xffffu); }
  __syncthreads();
#undef SLOAD
#undef SWRITE
#undef SWAIT
#undef RESC
}
#undef SBAR
}

struct Ctx { int tid, lane, wave, G, bx, vcu; char* lds; };

__device__ __forceinline__ void phase_mods(const Params& p, const Ctx& c_in) {
  Ctx c = c_in; c.tid = opaque(c_in.tid); c.lane = c.tid & 63; c.wave = __builtin_amdgcn_readfirstlane(c.tid >> 6);
  float* sl = (float*)c.lds;
  float* red = sl + 5 * 2048;
  for (int i = c.tid; i < 5 * 2048; i += 512) { const int r = i >> 11, k = i & 2047; const float v = r < 4 ? p.c[r * 2048 + k] : p.c_ctx[k]; sl[i] = v * fsigmoid(v); }
  __syncthreads();
  float* mods = (float*)(p.ws + WS_MODS);
  for (int ch = c.bx; ch < 256; ch += c.G) {
    const int l = ch >> 7, n0 = (ch & 127) * 96;
    const int cgp = c.tid % 24, ks = c.tid / 24;
    float a[5][4];
#pragma unroll
    for (int r = 0; r < 5; ++r)
#pragma unroll
      for (int j = 0; j < 4; ++j) a[r][j] = 0.f;
    if (c.tid < 384) {
      const float* W = p.ada_w + (size_t)l * 2048 * 12288 + n0 + 4 * cgp;
      for (int k = ks; k < 2048; k += 16) { const f32x4 w = *(const f32x4*)(W + (size_t)k * 12288);
#pragma unroll
        for (int r = 0; r < 5; ++r) { const float s = sl[r * 2048 + k];
#pragma unroll
          for (int j = 0; j < 4; ++j) a[r][j] += s * w[j]; } }
#pragma unroll
      for (int r = 0; r < 5; ++r)
#pragma unroll
        for (int j = 0; j < 4; ++j) red[(ks * 24 + cgp) * 20 + r * 4 + j] = a[r][j];
    }
    __syncthreads();
    if (c.tid < 480) { const int r = c.tid / 96, n = c.tid % 96, cg2 = n >> 2, j = n & 3; float s = 0.f;
      for (int q = 0; q < 16; ++q) s += red[(q * 24 + cg2) * 20 + r * 4 + j];
      mods[((size_t)l * 5 + r) * 12288 + n0 + n] = s + p.ada_b[l * 12288 + n0 + n]; }
    __syncthreads();
  }
}
__device__ __forceinline__ void phase_tables(const Params& p, const Ctx& c_in) {
  Ctx c = c_in; c.tid = opaque(c_in.tid); c.lane = c.tid & 63; c.wave = __builtin_amdgcn_readfirstlane(c.tid >> 6);
  float* T = (float*)c.lds;
  for (int i = c.tid; i < 4096; i += 512) T[i] = cosf((float)i * (6.283185307179586f / 4096.f)) * (1.f / 64.f);
  __syncthreads();
  const long gt = (long)c.bx * 512 + c.tid, GT = (long)c.G * 512;
  float* rc = (float*)(p.ws + WS_ROPEC); float* rs = (float*)(p.ws + WS_ROPES);
  for (long i = gt; i < 4096 * 32; i += GT) { const int pos = (int)(i >> 5), f = (int)(i & 31);
    const float inv = powf(10000.f, -(float)(f & 15) / 16.f); const float ang = (float)(f < 16 ? (pos >> 6) : (pos & 63)) * inv;
    rc[i] = cosf(ang); rs[i] = sinf(ang); }
  { bf16_t* fa = (bf16_t*)(p.ws + WS_FFTA); bf16_t* fc = (bf16_t*)(p.ws + WS_FFTC); float* twc = (float*)(p.ws + WS_TWC); float* tws = (float*)(p.ws + WS_TWS);
    for (long i = gt; i < 256 * 128; i += GT) { const int rho = (int)(i >> 7), kap = (int)(i & 127), cc = kap >> 6, nn = kap & 63;
      float va = 0.f, vc = 0.f;
      if (rho < 128) { const int wr_ = rho >> 6, m_ = (rho >> 4) & 3, fr_ = rho & 15, k1 = 32 * wr_ + 16 * (m_ & 1) + fr_, isim = m_ >> 1, r = (k1 * nn) & 63;
        const float cs_ = T[(64 * r) & 4095] * 8.f, sn_ = T[(64 * r + 3072) & 4095] * 8.f;
        va = isim ? (cc ? -cs_ : -sn_) : (cc ? -sn_ : cs_); }
      if (rho < 64) { const int r = (rho * nn) & 63; vc = cc ? T[(64 * r + 3072) & 4095] * 8.f : T[(64 * r) & 4095] * 8.f; }
      fa[i] = (bf16_t)(cvt_pk(va, 0.f) & 0xffffu); fc[i] = (bf16_t)(cvt_pk(vc, 0.f) & 0xffffu); }
    for (long i = gt; i < 64 * 64; i += GT) { const int k1 = (int)(i >> 6), n2 = (int)(i & 63), r = k1 * n2; twc[i] = T[r & 4095] * 64.f; tws[i] = T[(r + 3072) & 4095] * 64.f; } }
  bf16_t* dc = (bf16_t*)(p.ws + WS_DFTC);
  for (long i = gt; i < 256 * 512; i += GT) { const int m = (int)(i >> 9), kk = (int)(i & 511), n = kk & 255, s = kk >> 8;
    dc[i] = (bf16_t)(cvt_pk(T[(((m * n + 64 * s) & 255) * 16) & 4095] * 4.f, 0.f) & 0xffffu); }
  bf16_t* cs = (bf16_t*)(p.ws + WS_CS1);
  for (long i = gt; i < 256 * 128; i += GT) { const int jp = (int)(i >> 7), j = (int)(i & 127), l = jp & 127, s = jp >> 7;
    cs[i] = (bf16_t)(cvt_pk(T[(((l * j) & 127) * 32 + 3072 * s) & 4095] * 5.656854249492381f, 0.f) & 0xffffu); }
  __syncthreads();
}

enum { J_IN = 0, J_F, J_C, J_UQ, J_UKV, J_MLA, J_OUT, J_GU, J_DN, J_NUM };
struct WJob { const float* src; const float* src2; const float* gain; bf16_t* dst; int K, Nd, ldn, kind; };
__device__ __forceinline__ const float* wsrc(const WJob& j, int n0) {
  const int tile = n0 >> 8, r = n0 & 255;
  switch (j.kind) {
    case J_IN:
      if (tile < 4) return j.src + n0;
      if (tile < 12) { const int t = tile - 4; return j.src + (r < 128 ? F_END + 128 * t + r : F_END + 1024 + 128 * t + (r - 128)); }
      if (tile < 15) return j.src + C_END + (n0 - 12 * 256);
      if (tile < 17) return j.src + Q_END + (n0 - 15 * 256);
      if (tile == 17) return r == 0 ? j.src + KV_END : (r == 128 ? j.src + KV_END + 32 : nullptr);
      return j.src + KPE_END + (n0 - 18 * 256);
    case J_UQ:
      if (tile < 8) return j.src + (n0 >> 7) * 192 + (n0 & 127);
      { const int t = tile - 8, bj = r >> 7, wc = (r >> 5) & 3; return j.src + (4 * t + wc) * 192 + 128 + bj * 32; }
    case J_UKV:
      if (tile < 8) return j.src + (n0 >> 7) * 256 + (n0 & 127);
      { const int n1 = n0 - 2048; return j.src + (n1 >> 7) * 256 + 128 + (n1 & 127); }
    case J_GU:
      return (r < 128 ? j.src : j.src2) + 128 * tile + (r & 127);
    default: return j.src + n0;
  }
}
__device__ __forceinline__ void transpose_item(const WJob& j, int item, LAS float* scr, int lane) {
  const int nblk = j.Nd / 64, kb = item / nblk, nb = item % nblk, k0 = 64 * kb, n0 = 64 * nb;
  const int col4 = (lane & 15) * 4;
  const float* s = wsrc(j, n0 + (col4 & 32));
  f32x4 v[16];
#pragma unroll
  for (int i = 0; i < 16; ++i) { const int kk = 4 * i + (lane >> 4); v[i] = (f32x4){0.f, 0.f, 0.f, 0.f};
    if (s) { v[i] = *(const f32x4*)(s + (size_t)(k0 + kk) * j.ldn + (col4 & 31)); if (j.gain) v[i] = v[i] * j.gain[k0 + kk]; } }
#pragma unroll
  for (int i = 0; i < 16; ++i) { const int kk = 4 * i + (lane >> 4);
#pragma unroll
    for (int e = 0; e < 4; ++e) scr[kk * 65 + col4 + e] = v[i][e]; }
  asm volatile("s_waitcnt lgkmcnt(0)" ::: "memory");
  const int cch = lane & 7;
#pragma unroll
  for (int q = 0; q < 8; ++q) { const int n = (lane >> 3) + 8 * q; const LAS float* t = scr + (8 * cch) * 65 + n;
    u32x4 o; o.x = cvt_pk(t[0 * 65], t[1 * 65]); o.y = cvt_pk(t[2 * 65], t[3 * 65]); o.z = cvt_pk(t[4 * 65], t[5 * 65]); o.w = cvt_pk(t[6 * 65], t[7 * 65]);
    *(u32x4*)(j.dst + (size_t)(n0 + n) * j.K + k0 + 8 * cch) = o; }
  asm volatile("s_waitcnt lgkmcnt(0)" ::: "memory");
}
__device__ __forceinline__ void phase_wconv(const Params& p, const Ctx& c_in, int l) {
  Ctx c = c_in; c.tid = opaque(c_in.tid); c.lane = c.tid & 63; c.wave = __builtin_amdgcn_readfirstlane(c.tid >> 6);
  LAS float* scr = (LAS float*)((LAS unsigned char*)c.lds + c.wave * 16640);
  const int gw = c.vcu * 8 + c.wave, NGW = c.G * 8;
  unsigned char* ws = p.ws;
#pragma unroll 1
  for (int jk = 0; jk < J_NUM; ++jk) {
    WJob j; j.src2 = nullptr; j.gain = nullptr; j.kind = jk;
    switch (jk) {
      case J_IN: j.src = p.w_in + (size_t)l * 2048 * IN_COLS; j.dst = (bf16_t*)(ws + WS_WIN); j.K = 2048; j.Nd = 10752; j.ldn = IN_COLS; break;
      case J_F: j.src = p.w_fourier + (size_t)l * 1024 * 2048; j.dst = (bf16_t*)(ws + WS_WF); j.K = 1024; j.Nd = 2048; j.ldn = 2048; break;
      case J_C: j.src = p.w_conv_out + (size_t)l * 1024 * 2048; j.dst = (bf16_t*)(ws + WS_WC); j.K = 1024; j.Nd = 2048; j.ldn = 2048; break;
      case J_UQ: j.src = p.w_uq + (size_t)l * 768 * 3072; j.gain = p.q_norm_g + l * 768; j.dst = (bf16_t*)(ws + WS_WUQ); j.K = 768; j.Nd = 3072; j.ldn = 3072; break;
      case J_UKV: j.src = p.w_ukv + (size_t)l * 512 * 4096; j.gain = p.kv_norm_g + l * 512; j.dst = (bf16_t*)(ws + WS_WUKV); j.K = 512; j.Nd = 4096; j.ldn = 4096; break;
      case J_MLA: j.src = p.w_mla_o + (size_t)l * 2048 * 2048; j.dst = (bf16_t*)(ws + WS_WMLA); j.K = 2048; j.Nd = 2048; j.ldn = 2048; break;
      case J_OUT: j.src = p.w_out + (size_t)l * 2048 * 2048; j.dst = (bf16_t*)(ws + WS_WOUT); j.K = 2048; j.Nd = 2048; j.ldn = 2048; break;
      case J_GU: j.src = p.w_ffn_gate + (size_t)l * 2048 * FFH; j.src2 = p.w_ffn_up + (size_t)l * 2048 * FFH; j.dst = (bf16_t*)(ws + WS_WGU); j.K = 2048; j.Nd = 2 * FFH; j.ldn = FFH; break;
      default: j.src = p.w_ffn_down + (size_t)l * FFH * 2048; j.dst = (bf16_t*)(ws + WS_WDN); j.K = FFH; j.Nd = 2048; j.ldn = 2048; break;
    }
    const int nitems = (j.K / 64) * (j.Nd / 64);
    for (int it = gw; it < nitems; it += NGW) transpose_item(j, it, scr, c.lane);
  }
}
__device__ __forceinline__ void phase_normmod(const Params& p, const Ctx& c_in, const float* xl, const float* xc, const float* gain, const float* mods_l, int sh_idx, int nrows, bf16_t* hout,
                                              const float* part, const float* pgate, float* xstore) {
  Ctx c = c_in; c.tid = opaque(c_in.tid); c.lane = c.tid & 63; c.wave = __builtin_amdgcn_readfirstlane(c.tid >> 6);
  const int gw = c.vcu * 8 + c.wave, NGW = c.G * 8;
  for (int row = gw; row < nrows; row += NGW) {
    const float* xr = row < MX ? xl + (size_t)row * 2048 : xc + (size_t)(row - MX) * 2048;
    const float* md = mods_l + modgrp(row) * 12288;
    f32x4 v[8]; float ss = 0.f;
#pragma unroll
    for (int q = 0; q < 8; ++q) { const int col = q * 256 + c.lane * 4; v[q] = *(const f32x4*)(xr + col);
      if (part && row >= MX) { const float* pr = part + (size_t)(row - MX) * 2048 + col; const size_t ps = (size_t)1024 * 2048;
        const f32x4 sum = (*(const f32x4*)pr + *(const f32x4*)(pr + ps)) + (*(const f32x4*)(pr + 2 * ps) + *(const f32x4*)(pr + 3 * ps));
        v[q] = v[q] + *(const f32x4*)(pgate + col) * sum; if (xstore) *(f32x4*)(xstore + (size_t)(row - MX) * 2048 + col) = v[q]; }
      ss += (v[q][0] * v[q][0] + v[q][1] * v[q][1]) + (v[q][2] * v[q][2] + v[q][3] * v[q][3]); }
    const float rstd = 1.0f / sqrtf(wave_sum(ss) * (1.f / 2048.f) + EPS);
#pragma unroll
    for (int q = 0; q < 8; ++q) { const int col = q * 256 + c.lane * 4; const f32x4 g = *(const f32x4*)(gain + col), sh = *(const f32x4*)(md + sh_idx * 2048 + col), sc = *(const f32x4*)(md + (sh_idx + 1) * 2048 + col);
      const f32x4 y = v[q] * rstd * g * (sc + 1.f) + sh; u32x2 w; w.x = cvt_pk(y[0], y[1]); w.y = cvt_pk(y[2], y[3]);
      *(u32x2*)(hout + (size_t)row * 2048 + col) = w; }
  }
}
__device__ __forceinline__ void phase_conv(const Params& p, const Ctx& c_in, int l, int nrows, int cidx) {
  Ctx c = c_in; c.tid = opaque(c_in.tid); c.lane = c.tid & 63; c.wave = __builtin_amdgcn_readfirstlane(c.tid >> 6);
  constexpr int TT = 16, HALO = 15, NR = TT + 2 * HALO;
  const bf16_t* vb = (const bf16_t*)(p.ws + WS_VB); bf16_t* ob = (bf16_t*)(p.ws + WS_CBF);
  unsigned* tile = (unsigned*)c.lds;
  f32x2* red = (f32x2*)(c.lds + NR * 2048);
  const int ch = 2 * c.tid;
  float w0[31], w1[31];
#pragma unroll
  for (int k = 0; k < 31; ++k) { const f32x2 w = *(const f32x2*)(p.conv_w + ((size_t)l * 31 + k) * 1024 + ch); w0[k] = w[0]; w1[k] = w[1]; }
  const f32x2 cb = *(const f32x2*)(p.conv_b + l * 1024 + ch), lg = *(const f32x2*)(p.conv_ln_g + l * 1024 + ch), lb = *(const f32x2*)(p.conv_ln_b + l * 1024 + ch);
  const int ntiles = nrows / TT;
  for (int t = cidx; t < ntiles; t += c.G) {
    const int r0 = t * TT; const int seqlen = r0 < MX ? SEQ : CTXL; const int sbeg = r0 < MX ? (r0 & ~(SEQ - 1)) : MX + ((r0 - MX) & ~(CTXL - 1)); const int send = sbeg + seqlen;
    for (int i = c.tid; i < NR * 128; i += 512) { const int rr = i >> 7, cc = i & 127, row = r0 - HALO + rr; u32x4 v = {0u, 0u, 0u, 0u};
      if (row >= sbeg && row < send) v = *(const u32x4*)(vb + (size_t)row * 1024 + cc * 8);
      *(u32x4*)(tile + rr * 512 + cc * 4) = v; }
    __syncthreads();
    float y0[TT], y1[TT];
#pragma unroll
    for (int tt = 0; tt < TT; ++tt) { float a0 = cb[0], a1 = cb[1];
#pragma unroll
      for (int k = 0; k < 31; ++k) { const unsigned w = tile[(tt + k) * 512 + c.tid]; a0 += bflo(w) * w0[k]; a1 += bfhi(w) * w1[k]; }
      y0[tt] = a0; y1[tt] = a1;
      const float s = wave_sum(a0 + a1), q = wave_sum(a0 * a0 + a1 * a1);
      if (c.lane == 0) red[tt * 8 + c.wave] = (f32x2){s, q}; }
    __syncthreads();
#pragma unroll
    for (int tt = 0; tt < TT; ++tt) { float s = 0.f, q = 0.f;
#pragma unroll
      for (int w = 0; w < 8; ++w) { const f32x2 r = red[tt * 8 + w]; s += r[0]; q += r[1]; }
      const float mu = s * (1.f / 1024.f); const float var = fmaxf(q * (1.f / 1024.f) - mu * mu, 0.f); const float rstd = 1.0f / sqrtf(var + EPS);
      float z0 = (y0[tt] - mu) * rstd * lg[0] + lb[0], z1 = (y1[tt] - mu) * rstd * lg[1] + lb[1];
      z0 = z0 * fsigmoid(z0); z1 = z1 * fsigmoid(z1);
      *(unsigned*)(ob + (size_t)(r0 + tt) * 1024 + ch) = cvt_pk(z0, z1); }
    __syncthreads();
  }
}
__device__ __forceinline__ void phase_final(const Params& p, const Ctx& c_in) {
  Ctx c = c_in; c.tid = opaque(c_in.tid); c.lane = c.tid & 63; c.wave = __builtin_amdgcn_readfirstlane(c.tid >> 6);
  const int gw = c.vcu * 8 + c.wave, NGW = c.G * 8;
  for (int row = gw; row < MX; row += NGW) { float* xr = p.out + (size_t)row * 2048; f32x4 v[8]; float ss = 0.f;
#pragma unroll
    for (int q = 0; q < 8; ++q) { v[q] = *(const f32x4*)(xr + q * 256 + c.lane * 4); ss += (v[q][0] * v[q][0] + v[q][1] * v[q][1]) + (v[q][2] * v[q][2] + v[q][3] * v[q][3]); }
    const float rstd = 1.0f / sqrtf(wave_sum(ss) * (1.f / 2048.f) + EPS);
#pragma unroll
    for (int q = 0; q < 8; ++q) { const int col = q * 256 + c.lane * 4; *(f32x4*)(xr + col) = v[q] * rstd * *(const f32x4*)(p.final_norm_g + col); } }
}

constexpr int LDS_BYTES = 147456;
__device__ __forceinline__ void grid_barrier(unsigned char* ws, volatile LAS unsigned* nbar_lds) {
  asm volatile("s_waitcnt vmcnt(0) lgkmcnt(0)" ::: "memory");
  __syncthreads();
  if (threadIdx.x == 0) {
    unsigned* bar = (unsigned*)(ws + WS_FLAGS); const unsigned G = gridDim.x, nbar = *nbar_lds;
    __builtin_amdgcn_fence(__ATOMIC_RELEASE, "agent"); asm volatile("s_waitcnt vmcnt(0)" ::: "memory");
    const unsigned old = __hip_atomic_fetch_add(bar, 1u, __ATOMIC_RELAXED, __HIP_MEMORY_SCOPE_AGENT);
    if (old + 1u == G * (nbar + 1u)) __hip_atomic_store(bar + 64, nbar + 1u, __ATOMIC_RELAXED, __HIP_MEMORY_SCOPE_AGENT);
    else while (__hip_atomic_load(bar + 64, __ATOMIC_RELAXED, __HIP_MEMORY_SCOPE_AGENT) <= nbar) __builtin_amdgcn_s_sleep(2);
    __builtin_amdgcn_fence(__ATOMIC_ACQUIRE, "agent"); asm volatile("s_waitcnt vmcnt(0)" ::: "memory");
    *nbar_lds = nbar + 1u;
  }
  __syncthreads();
}
enum { SK_NONE = 0, SK_GEMM, SK_P0, SK_CONV, SK_ATT, SK_NORM2, SK_CMERGE };
constexpr int NSTEP = 31;
__device__ __forceinline__ Params load_params() { KArgP ka = kargs(); Params P; __builtin_memcpy(&P, (const void*)ka, sizeof(Params)); return P; }
__global__ void __launch_bounds__(512, 2) mk_fwd(Params p_unused) {
  extern __shared__ __attribute__((aligned(16))) unsigned char lds_raw[];
  cg::grid_group grid = cg::this_grid();
  Ctx c; c.tid = threadIdx.x; c.lane = c.tid & 63; c.wave = __builtin_amdgcn_readfirstlane(c.tid >> 6); c.G = gridDim.x; c.bx = blockIdx.x;
  c.vcu = (c.G % 8 == 0) ? (c.bx % 8) * (c.G / 8) + c.bx / 8 : c.bx; c.lds = (char*)lds_raw;
  LAS unsigned char* lds3 = (LAS unsigned char*)lds_raw;
  unsigned char* ws = kargs()->ws;
  const int G = c.G;

  volatile LAS unsigned* nbar_lds = (volatile LAS unsigned*)(lds3 + LDS_BYTES - 64);
  if (c.tid == 0) *nbar_lds = 0u;
  grid.sync();
  { const Params P = load_params(); phase_mods(P, c); phase_tables(P, c); }
  grid_barrier(ws, nbar_lds);

#pragma unroll 1
  for (int l = 0; l < 2; ++l) {
    const int nM = l == 0 ? 68 : 64;
    int base = 0;
#pragma unroll 1
    for (int st = 0; st < NSTEP; ++st) {
      int kind = SK_GEMM, sync = 0, K = 2048, oM = nM, oN = 8, rot = 0;
      size_t aofs = WS_H, bofs = WS_WIN;
      pg8::Epi E{}; E.l = l; E.ws = ws; pg8::Geo g{}; g.mode = pg8::GEO_STD; g.lda = 2048; g.ldb = 2048;
      const int sx = st < 8 ? st : (st == 8 ? 100 : st - 1);
      switch (sx) {
        case 0: kind = SK_P0; sync = 1; break;
        case 1:
          E.mode = pg8::E_IN; oN = 18; sync = (l == 0); break;
        case 2:
          if (l == 0) { kind = SK_NONE; break; }
          E.mode = pg8::E_IN; E.pm_off = 64; E.pn_off = 15; aofs = WS_H + (size_t)MX * 2048 * 2; bofs = WS_WIN + (size_t)15 * 256 * 2048 * 2; oM = 4; oN = 3; rot = 64 * 18; sync = 1; break;
        case 3:
          E.mode = pg8::E_DFT1; g.mode = pg8::GEO_DFT1; g.lda = 128; g.ldb = 1024; aofs = WS_CS1; bofs = WS_UF; K = 128; oM = 1; oN = 512; base = 0; break;
        case 4:
          if (l != 0) { kind = SK_NONE; break; }
          E.mode = pg8::E_DFT1; E.aux = 1; g.mode = pg8::GEO_DFT1; g.aux = 1; g.lda = 128; g.ldb = 1024; aofs = WS_CS1; bofs = WS_UF + (size_t)MX * 1024 * 2; K = 128; oM = 1; oN = 32; rot = base; break;
        case 5:
          E.mode = pg8::E_UQ; g.lda = 768; g.ldb = 768; aofs = WS_QD; bofs = WS_WUQ; K = 768; oN = 12; rot = base; break;
        case 6:
          E.mode = pg8::E_UKV; g.lda = 512; g.ldb = 512; aofs = WS_KVD; bofs = WS_WUKV; K = 512; oM = 68; oN = 16; rot = base; break;
        case 7: kind = SK_CONV; rot = base; sync = 1; break;
        case 8: kind = SK_ATT; break;
        case 100:
          E.mode = pg8::E_FFTA; g.mode = pg8::GEO_A0; g.lda = 128; g.ldb = 128; aofs = WS_FFTA; bofs = WS_ZT; K = 128; oM = 1; oN = 1024; sync = 1; break;
        case 9:
          E.mode = pg8::E_FFTC; g.mode = pg8::GEO_A0; g.lda = 128; g.ldb = 128; aofs = WS_FFTC; bofs = WS_GP; K = 128; oM = 1; oN = 1024; sync = (l != 0); break;
        case 10:
          if (l != 0) { kind = SK_NONE; break; }
          E.mode = pg8::E_DFT2; E.aux = 1; g.mode = pg8::GEO_DFT2; g.aux = 1; g.lda = 512; g.ldb = 512; aofs = WS_DFTC; bofs = WS_ZTC; K = 512; oM = 1; oN = 16; rot = G - 64; sync = 1; break;
        case 11: case 13: case 15: {
          const int br = (sx - 11) >> 1; E.mode = pg8::E_GATE; E.aux = br; oM = 64; bofs = WS_WIN + (size_t)(18 * 256 + br * 2048) * 2048 * 2; break; }
        case 12: case 14: case 16: {
          const int br = (sx - 12) >> 1; E.mode = pg8::E_Y; E.aux = (br == 0); oM = 64;
          K = br == 2 ? 2048 : 1024; g.lda = K; g.ldb = K;
          aofs = br == 0 ? WS_F : (br == 1 ? WS_CBF : WS_O); bofs = br == 0 ? WS_WF : (br == 1 ? WS_WC : WS_WMLA);
          sync = (br == 2 && l != 0); break; }
        case 17: case 18: case 19: {
          if (l != 0) { kind = SK_NONE; break; }
          const int br = sx - 17; E.mode = pg8::E_GATE; E.aux = 4 + br; E.pm_off = 64; oM = 4; rot = 32 * (sx - 17);
          aofs = WS_H + (size_t)MX * 2048 * 2; bofs = WS_WIN + (size_t)(18 * 256 + br * 2048) * 2048 * 2; break; }
        case 20: case 21: case 22: {
          if (l != 0) { kind = SK_NONE; break; }
          const int br = sx - 20; E.mode = pg8::E_YC; E.aux = br; E.pm_off = 64; oM = 4; rot = 32 * (sx - 17);
          K = br == 2 ? 2048 : 1024; g.lda = K; g.ldb = K;
          aofs = (br == 0 ? WS_F : (br == 1 ? WS_CBF : WS_O)) + (size_t)MX * K * 2; bofs = br == 0 ? WS_WF : (br == 1 ? WS_WC : WS_WMLA);
          sync = (br == 2); break; }
        case 23: if (l != 0) { kind = SK_NONE; break; } kind = SK_CMERGE; sync = 1; break;
        case 24:
          E.mode = pg8::E_RES; E.aux = 0; oM = 64; aofs = WS_MERGED; bofs = WS_WOUT; sync = (l != 0); break;
        case 25:
          if (l != 0) { kind = SK_NONE; break; }
          E.mode = pg8::E_RES; E.aux = 8; E.pm_off = 64; g.mode = pg8::GEO_SPLITK; g.aux = 512; K = 512; oM = 4; oN = 32;
          aofs = WS_MERGED + (size_t)MX * 2048 * 2; bofs = WS_WOUT; sync = 1; break;
        case 26: kind = SK_NORM2; sync = 1; break;
        case 27:
          E.mode = pg8::E_UP; bofs = WS_WGU; oN = 44; sync = 1; break;
        case 28:
          E.mode = pg8::E_RES; E.aux = 1; oM = 64; g.lda = FFH; g.ldb = FFH; aofs = WS_HID; bofs = WS_WDN; K = FFH; sync = (l != 0); break;
        default:
          if (l != 0) { kind = SK_NONE; break; }
          E.mode = pg8::E_RES; E.aux = 9; E.pm_off = 64; g.mode = pg8::GEO_SPLITK; g.aux = 1408; g.lda = FFH; g.ldb = FFH; K = 1408; oM = 4; oN = 32;
          aofs = WS_HID + (size_t)MX * FFH * 2; bofs = WS_WDN; sync = 1; break;
      }
      if (kind == SK_GEMM) {
        pg8::Order S; S.init(oM, oN, G, (c.bx + G - rot % G) % G);
#ifndef NO_GEMM
        pg8::gemm_phase(lds3, (const bf16_t*)(ws + aofs), (const bf16_t*)(ws + bofs), K, S, g, E);
#endif
        base += oM * oN;
      } else if (kind == SK_P0) {
        const Params P = load_params();
        const float* mods_l = (const float*)(ws + WS_MODS) + (size_t)l * 5 * 12288;
        phase_wconv(P, c, l);
        phase_normmod(P, c, l == 0 ? P.x : P.out, l == 0 ? P.ctx : (const float*)(ws + WS_CTXX), P.norm_mix_g + l * 2048, mods_l, 0, MT, (bf16_t*)(ws + WS_H),
                      l == 0 ? nullptr : (const float*)(ws + WS_PART), (const float*)(ws + WS_MODS) + 4 * 12288 + 5 * 2048, nullptr);
        float* ssq_q = (float*)(ws + WS_SSQQ); float* ssq_kv = (float*)(ws + WS_SSQKV);
        for (int i = c.bx * 512 + opaque(c.tid); i < MT; i += G * 512) { ssq_q[i] = 0.f; ssq_kv[i] = 0.f; }
      } else if (kind == SK_CONV) {
        __syncthreads();
        const Params P = load_params();
#ifndef NO_CONV
        phase_conv(P, c, l, nM * 256, (c.bx + G - rot % G) % G);
#endif
      } else if (kind == SK_ATT) {
        const bf16_t* Qp = (const bf16_t*)(ws + WS_Q); const bf16_t* Kp = (const bf16_t*)(ws + WS_KN); const bf16_t* KPp = (const bf16_t*)(ws + WS_KPE); const bf16_t* Vp = (const bf16_t*)(ws + WS_V);
        bf16_t* Op = (bf16_t*)(ws + WS_O);
#ifndef NO_ATT
#pragma unroll 1
        for (int u = c.vcu; u < 1024 + (l == 0 ? 64 : 0); u += G) {
          int b, h, qrow, krow0, seq;
          if (u < 1024) { const int bh = u >> 4, qb = u & 15; b = bh >> 4; h = bh & 15; qrow = b * SEQ + qb * 256; krow0 = b * KVS; seq = KVS; }
          else { const int uc = u - 1024; b = uc >> 4; h = uc & 15; qrow = MX + b * CTXL; krow0 = b * KVS + SEQ; seq = CTXL; }
          att::attn_body(Qp + (size_t)qrow * 3072 + h * 192, Kp + (size_t)krow0 * 2048 + h * 128, KPp + (size_t)krow0 * 64, Vp + (size_t)krow0 * 2048 + h * 128,
                         Op + (size_t)qrow * 2048 + h * 128, seq, c.lds);
        }
#endif
        __syncthreads();
      } else if (kind == SK_CMERGE) {
        const u32x4* gc = (const u32x4*)(ws + WS_GATEC); const u32x4* yc = (const u32x4*)(ws + WS_YC); u32x4* mo = (u32x4*)((bf16_t*)(ws + WS_MERGED) + (size_t)MX * 2048);
        const int n8 = 1024 * 2048 / 8;
        for (int i = c.bx * 512 + opaque(c.tid); i < n8; i += G * 512) { f32x4 a0 = {0.f, 0.f, 0.f, 0.f}, a1 = a0;
#pragma unroll
          for (int b = 0; b < 3; ++b) { const u32x4 gw = gc[i + b * n8], yw = yc[i + b * n8];
            a0[0] += bflo(gw.x) * bflo(yw.x); a0[1] += bfhi(gw.x) * bfhi(yw.x); a0[2] += bflo(gw.y) * bflo(yw.y); a0[3] += bfhi(gw.y) * bfhi(yw.y);
            a1[0] += bflo(gw.z) * bflo(yw.z); a1[1] += bfhi(gw.z) * bfhi(yw.z); a1[2] += bflo(gw.w) * bflo(yw.w); a1[3] += bfhi(gw.w) * bfhi(yw.w); }
          mo[i] = pack8(a0, a1); }
      } else if (kind == SK_NORM2) {
        const Params P = load_params();
        const float* mods_l = (const float*)(ws + WS_MODS) + (size_t)l * 5 * 12288;
        phase_normmod(P, c, P.out, l == 0 ? P.ctx : (const float*)(ws + WS_CTXX), P.norm_ffn_g + l * 2048, mods_l, 3, nM * 256, (bf16_t*)(ws + WS_H),
                      l == 0 ? (const float*)(ws + WS_PART) : nullptr, mods_l + 4 * 12288 + 2 * 2048, l == 0 ? (float*)(ws + WS_CTXX) : nullptr);
      }
      if (sync) grid_barrier(ws, nbar_lds);
    }
  }
#ifdef CUT
  grid_barrier(ws, nbar_lds);
  { const Params P = load_params(); const long N = (long)MX * DM; const bf16_t* wb = (const bf16_t*)(ws + WS_H); const long NB16 = (long)(WS_END - WS_H) / 2;
    const float* misc = (const float*)ws;
    for (long i = (long)c.bx * 512 + c.tid; i < N; i += (long)G * 512) { float a = P.out[i];
      for (long e = i; e < NB16; e += N) a += __uint_as_float(((unsigned)wb[e]) << 16);
      if (i < (long)(3 * MiB)) a += misc[i];
      P.out[i] = a; } }
#else
  { const Params P = load_params(); phase_final(P, c); }
#endif
}

extern "C" void kernel_launch(void* const* d_in, const int* in_sizes, int n_in, void* d_out, int out_size, void* d_ws, size_t ws_size, hipStream_t stream) {
  static int grid_blocks = 0;
  if (!grid_blocks) {
    if (n_in != 26 || out_size != MX * DM || ws_size < WS_END) { fprintf(stderr, "kernel_launch: unexpected shapes / workspace (%d inputs, out %d, ws %zu < %zu)\n", n_in, out_size, ws_size, (size_t)WS_END); grid_blocks = -1; return; }
    int dev = 0, cus = 0, per_cu = 0;
    (void)hipGetDevice(&dev);
    (void)hipDeviceGetAttribute(&cus, hipDeviceAttributeMultiprocessorCount, dev);
    if (hipFuncSetAttribute((const void*)mk_fwd, hipFuncAttributeMaxDynamicSharedMemorySize, LDS_BYTES) != hipSuccess) { fprintf(stderr, "hipFuncSetAttribute failed\n"); grid_blocks = -1; return; }
    (void)hipOccupancyMaxActiveBlocksPerMultiprocessor(&per_cu, (const void*)mk_fwd, 512, LDS_BYTES);
    (void)hipGetLastError();
    grid_blocks = cus;
  }
  if (grid_blocks < 0) return;
  if (hipMemsetAsync(d_ws, 0, 1024, stream) != hipSuccess) { fprintf(stderr, "memset of barrier words failed\n"); return; }
  Params p{};
  const float** pp = (const float**)&p;
  for (int i = 0; i < 26; ++i) pp[i] = (const float*)d_in[i];
  p.out = (float*)d_out; p.ws = (unsigned char*)d_ws; p.ph_lo = 0; p.ph_hi = 1000;
  void* args[] = {&p};
  hipError_t e = hipLaunchCooperativeKernel((void*)mk_fwd, dim3(grid_blocks), dim3(512), args, LDS_BYTES, stream);
  if (e != hipSuccess) fprintf(stderr, "cooperative launch failed: %s (grid %d)\n", hipGetErrorString(e), grid_blocks);
}
```
